# Optimizing an MI355X kernel written in HIP

```python
import math
import jax
import jax.numpy as jnp
from jax import lax
import numpy as np

D_MODEL = 1024
BATCH = 4
SEQ = 8192
DEPTH = 4

GRID_W = 64
CTX_LEN = 256
N_MIXERS = 4
Q_BLOCK = 128
ROPE_BASE = 10000.0
EPS = 1e-6
NEG_INF = -1e30

GQA_HEADS = 16
GQA_KV_HEADS = 4
GQA_HEAD_DIM = 64
MLA_HEADS = 16
MLA_NOPE_DIM = 64
MLA_ROPE_DIM = 32
MLA_V_DIM = 64
MLA_Q_LORA = 384
MLA_KV_LORA = 256
DIFF_HEADS = 8
DIFF_HEAD_DIM = 64
NA_HEADS = 16
NA_HEAD_DIM = 64
NA_ROWS = 8
NA_COLS = 16
NA_QROWS = Q_BLOCK // GRID_W
FFN_DIM = 2816

kernel_name = 'hybrid_prefix_dit_trunk'


def rms_norm(x, g):
    xf = x.astype(jnp.float32)
    y = xf * lax.rsqrt(jnp.mean(xf * xf, axis=-1, keepdims=True) + EPS)
    return (y * g.astype(jnp.float32)).astype(x.dtype)


def norm_modulate(h, g, shift, scale):
    return rms_norm(h, g) * (1 + scale) + shift


def softmax_f32(s):
    return jax.nn.softmax(s.astype(jnp.float32), axis=-1)


def axial_rope(n_tokens, rot_dim, dtype):
    t = jnp.arange(n_tokens)
    row = (t // GRID_W).astype(jnp.float32)
    col = (t % GRID_W).astype(jnp.float32)
    half = rot_dim // 2
    inv = ROPE_BASE ** (-jnp.arange(0, half, 2, dtype=jnp.float32) / half)
    ar, ac = row[:, None] * inv, col[:, None] * inv
    ang = jnp.concatenate([ar, ar, ac, ac], axis=-1)
    return jnp.cos(ang).astype(dtype), jnp.sin(ang).astype(dtype)


def apply_rope(x, cos, sin):
    x1, x2, x3, x4 = jnp.split(x, 4, axis=-1)
    rot = jnp.concatenate([-x2, x1, -x4, x3], axis=-1)
    shape = (cos.shape[0],) + (1,) * (x.ndim - 3) + (cos.shape[1],)
    return x * cos.reshape(shape) + rot * sin.reshape(shape)


def sweep_query_blocks(fn, *qs):
    b, t = qs[0].shape[:2]
    nb = t // Q_BLOCK
    blocks = tuple(jnp.moveaxis(q.reshape(b, nb, Q_BLOCK, *q.shape[2:]), 1, 0) for q in qs)
    out = lax.map(lambda qb: fn(*qb), blocks)
    return jnp.moveaxis(out, 0, 1).reshape(b, t, *out.shape[3:])


def gqa_mixer(hx, hc, w_in, q_g, k_g, w_out, ctx_out):
    b, t, d = hx.shape
    grp = GQA_HEADS // GQA_KV_HEADS
    splits = [GQA_HEADS * GQA_HEAD_DIM, (GQA_HEADS + GQA_KV_HEADS) * GQA_HEAD_DIM]

    def project(h):
        n = h.shape[1]
        q, k, v = jnp.split(h @ w_in, splits, axis=-1)
        q = rms_norm(q.reshape(b, n, GQA_KV_HEADS, grp, GQA_HEAD_DIM), q_g)
        k = rms_norm(k.reshape(b, n, GQA_KV_HEADS, GQA_HEAD_DIM), k_g)
        return q, k, v.reshape(b, n, GQA_KV_HEADS, GQA_HEAD_DIM)

    qx, kx, vx = project(hx)
    qc, kc, vc = project(hc)
    cos, sin = axial_rope(t, GQA_HEAD_DIM, hx.dtype)
    qx, kx = apply_rope(qx, cos, sin), apply_rope(kx, cos, sin)
    k_all = jnp.concatenate([kc, kx], axis=1)
    v_all = jnp.concatenate([vc, vx], axis=1)
    scale = GQA_HEAD_DIM ** -0.5

    def attend(q, k, v):
        s = jnp.einsum('bqhgd,bkhd->bhgqk', q, k) * scale
        p = softmax_f32(s).astype(v.dtype)
        return jnp.einsum('bhgqk,bkhd->bqhgd', p, v)

    out_x = sweep_query_blocks(lambda qb: attend(qb, k_all, v_all), qx).reshape(b, t, d) @ w_out
    out_c = attend(qc, kc, vc).reshape(b, hc.shape[1], d) @ w_out if ctx_out else None
    return out_x, out_c


def mla_mixer(hx, hc, w_in, q_norm_g, kv_norm_g, w_uq, w_ukv, w_out, ctx_out):
    b, t, d = hx.shape
    qk_dim = MLA_NOPE_DIM + MLA_ROPE_DIM

    def project(h):
        n = h.shape[1]
        cq, ckv, k_rope = jnp.split(h @ w_in, [MLA_Q_LORA, MLA_Q_LORA + MLA_KV_LORA], axis=-1)
        q = (rms_norm(cq, q_norm_g) @ w_uq).reshape(b, n, MLA_HEADS, qk_dim)
        kv = (rms_norm(ckv, kv_norm_g) @ w_ukv).reshape(b, n, MLA_HEADS, MLA_NOPE_DIM + MLA_V_DIM)
        q_nope, q_rope = jnp.split(q, [MLA_NOPE_DIM], axis=-1)
        k_nope, v = jnp.split(kv, [MLA_NOPE_DIM], axis=-1)
        return q_nope, q_rope, k_nope, k_rope, v

    qnx, qrx, knx, krx, vx = project(hx)
    qnc, qrc, knc, krc, vc = project(hc)
    cos, sin = axial_rope(t, MLA_ROPE_DIM, hx.dtype)
    qrx, krx = apply_rope(qrx, cos, sin), apply_rope(krx, cos, sin)
    kn_all = jnp.concatenate([knc, knx], axis=1)
    kr_all = jnp.concatenate([krc, krx], axis=1)
    v_all = jnp.concatenate([vc, vx], axis=1)
    scale = qk_dim ** -0.5

    def attend(qn, qr, kn, kr, v):
        s = (jnp.einsum('bqhd,bkhd->bhqk', qn, kn) + jnp.einsum('bqhd,bkd->bhqk', qr, kr)) * scale
        p = softmax_f32(s).astype(v.dtype)
        return jnp.einsum('bhqk,bkhd->bqhd', p, v)

    ox = sweep_query_blocks(lambda qn, qr: attend(qn, qr, kn_all, kr_all, v_all), qnx, qrx)
    out_x = ox.reshape(b, t, MLA_HEADS * MLA_V_DIM) @ w_out
    out_c = attend(qnc, qrc, knc, krc, vc).reshape(b, hc.shape[1], MLA_HEADS * MLA_V_DIM) @ w_out if ctx_out else None
    return out_x, out_c


def diff_mixer(hx, hc, w_in, lam, subln_g, w_out, layer_idx, ctx_out):
    b, t, d = hx.shape
    lambda_init = 0.8 - 0.6 * math.exp(-0.3 * layer_idx)
    lf = lam.astype(jnp.float32)
    lam_full = jnp.exp(jnp.sum(lf[0] * lf[1])) - jnp.exp(jnp.sum(lf[2] * lf[3])) + lambda_init

    def project(h):
        n = h.shape[1]
        q, k, v = jnp.split(h @ w_in, 3, axis=-1)
        q = q.reshape(b, n, DIFF_HEADS, 2, DIFF_HEAD_DIM)
        k = k.reshape(b, n, DIFF_HEADS, 2, DIFF_HEAD_DIM)
        return q, k, v.reshape(b, n, DIFF_HEADS, 2 * DIFF_HEAD_DIM)

    qx, kx, vx = project(hx)
    qc, kc, vc = project(hc)
    cos, sin = axial_rope(t, DIFF_HEAD_DIM, hx.dtype)
    qx, kx = apply_rope(qx, cos, sin), apply_rope(kx, cos, sin)
    k_all = jnp.concatenate([kc, kx], axis=1)
    v_all = jnp.concatenate([vc, vx], axis=1)
    scale = DIFF_HEAD_DIM ** -0.5

    def attend(q, k, v):
        s = jnp.einsum('bqhjd,bkhjd->bhjqk', q, k) * scale
        p = softmax_f32(s)
        p = p[:, :, 0] - lam_full * p[:, :, 1]
        o = jnp.einsum('bhqk,bkhe->bqhe', p.astype(v.dtype), v)
        return rms_norm(o, subln_g) * (1 - lambda_init)

    out_x = sweep_query_blocks(lambda qb: attend(qb, k_all, v_all), qx).reshape(b, t, d) @ w_out
    out_c = attend(qc, kc, vc).reshape(b, hc.shape[1], d) @ w_out if ctx_out else None
    return out_x, out_c


def na_mixer(hx, hc, w_in, rpb, w_out, ctx_out):
    b, t, d = hx.shape
    rows = t // GRID_W
    win_rows = min(NA_ROWS, rows)
    band_rows = min(win_rows + 1, rows)
    band = band_rows * GRID_W
    n_ctx = hc.shape[1]

    def project(h):
        n = h.shape[1]
        q, k, v = jnp.split(h @ w_in, 3, axis=-1)
        return tuple(a.reshape(b, n, NA_HEADS, NA_HEAD_DIM) for a in (q, k, v))

    qx, kx, vx = project(hx)
    qc, kc, vc = project(hc)
    scale = NA_HEAD_DIM ** -0.5
    k_grid = kx.reshape(b, rows, GRID_W, NA_HEADS, NA_HEAD_DIM)
    v_grid = vx.reshape(b, rows, GRID_W, NA_HEADS, NA_HEAD_DIM)
    nb = t // Q_BLOCK
    q_blocks = jnp.moveaxis(qx.reshape(b, nb, Q_BLOCK, NA_HEADS, NA_HEAD_DIM), 1, 0)
    q_off, k_off = jnp.arange(Q_BLOCK), jnp.arange(band)
    q_dr, q_col = q_off // GRID_W, q_off % GRID_W
    k_dr, k_col = k_off // GRID_W, k_off % GRID_W
    col_start = jnp.clip(q_col - NA_COLS // 2, 0, GRID_W - NA_COLS)
    col_in = (k_col[None, :] >= col_start[:, None]) & (k_col[None, :] < col_start[:, None] + NA_COLS)
    dc_idx = jnp.clip(k_col[None, :] - q_col[:, None] + NA_COLS - 1, 0, 2 * NA_COLS - 2)

    def block(args):
        j, qb = args
        r = j * NA_QROWS + q_dr
        row_start = jnp.clip(r - win_rows // 2, 0, rows - win_rows)
        b0 = jnp.minimum(row_start[0], rows - band_rows)
        k_band = lax.dynamic_slice_in_dim(k_grid, b0, band_rows, axis=1).reshape(b, band, NA_HEADS, NA_HEAD_DIM)
        v_band = lax.dynamic_slice_in_dim(v_grid, b0, band_rows, axis=1).reshape(b, band, NA_HEADS, NA_HEAD_DIM)
        k_row = b0 + k_dr
        in_win = col_in & (k_row[None, :] >= row_start[:, None]) & (k_row[None, :] < row_start[:, None] + win_rows)
        dr_idx = jnp.clip(k_row[None, :] - r[:, None] + NA_ROWS - 1, 0, 2 * NA_ROWS - 2)
        bias = rpb[:, dr_idx, dc_idx].astype(jnp.float32)
        s_lat = jnp.einsum('bqhd,bkhd->bhqk', qb, k_band).astype(jnp.float32) * scale + bias
        s_lat = jnp.where(in_win, s_lat, NEG_INF)
        s_ctx = jnp.einsum('bqhd,bkhd->bhqk', qb, kc).astype(jnp.float32) * scale
        p = softmax_f32(jnp.concatenate([s_ctx, s_lat], axis=-1)).astype(vx.dtype)
        return (jnp.einsum('bhqk,bkhd->bqhd', p[..., :n_ctx], vc)
                + jnp.einsum('bhqk,bkhd->bqhd', p[..., n_ctx:], v_band))

    ox = lax.map(block, (jnp.arange(nb), q_blocks))
    out_x = jnp.moveaxis(ox, 0, 1).reshape(b, t, d) @ w_out
    if ctx_out:
        s = jnp.einsum('bqhd,bkhd->bhqk', qc, kc) * scale
        p = softmax_f32(s).astype(vc.dtype)
        out_c = jnp.einsum('bhqk,bkhd->bqhd', p, vc).reshape(b, n_ctx, d) @ w_out
    else:
        out_c = None
    return out_x, out_c


def dwconv_centred(u, w, bias):
    p = jnp.pad(u, ((0, 0), (1, 1), (0, 0)))
    return p[:, :-2] * w[0] + p[:, 1:-1] * w[1] + p[:, 2:] * w[2] + bias


def conv_ffn(h, w_up, conv_w, conv_b, w_down):
    u = dwconv_centred(h @ w_up, conv_w, conv_b)
    val, gate = jnp.split(u, 2, axis=-1)
    return (jax.nn.silu(gate) * val) @ w_down


def setup_inputs(seed: int = 0) -> dict:
    key = jax.random.key(seed)
    ks = iter(jax.random.split(key, 32))
    D = D_MODEL

    def nrm(shape, scale=1.0):
        return jax.random.normal(next(ks), shape, jnp.float32) * scale

    def gain(shape):
        return 1.0 + nrm(shape, 0.02)

    la, lb, lc, ld = (len(range(m, DEPTH, N_MIXERS)) for m in range(N_MIXERS))
    gqa_in = (GQA_HEADS + 2 * GQA_KV_HEADS) * GQA_HEAD_DIM
    mla_in = MLA_Q_LORA + MLA_KV_LORA + MLA_ROPE_DIM
    return {
        'x': nrm((BATCH, SEQ, D)),
        'c': nrm((BATCH, D)),
        'ctx': nrm((BATCH, CTX_LEN, D)),
        'c_ctx': nrm((D,)),
        'ada_w': nrm((DEPTH, D, 6 * D), 0.5 * D ** -0.5),
        'ada_b': nrm((DEPTH, 6 * D), 0.02),
        'norm1_g': gain((DEPTH, D)),
        'norm2_g': gain((DEPTH, D)),
        'ffn_w_up': nrm((DEPTH, D, 2 * FFN_DIM), D ** -0.5),
        'ffn_conv_w': nrm((DEPTH, 3, 2 * FFN_DIM), 3 ** -0.5),
        'ffn_conv_b': nrm((DEPTH, 2 * FFN_DIM), 0.02),
        'ffn_w_down': nrm((DEPTH, FFN_DIM, D), FFN_DIM ** -0.5),
        'gqa_w_in': nrm((la, D, gqa_in), D ** -0.5),
        'gqa_q_norm_g': gain((la, GQA_HEAD_DIM)),
        'gqa_k_norm_g': gain((la, GQA_HEAD_DIM)),
        'gqa_w_out': nrm((la, GQA_HEADS * GQA_HEAD_DIM, D), (GQA_HEADS * GQA_HEAD_DIM) ** -0.5),
        'mla_w_in': nrm((lb, D, mla_in), D ** -0.5),
        'mla_q_norm_g': gain((lb, MLA_Q_LORA)),
        'mla_kv_norm_g': gain((lb, MLA_KV_LORA)),
        'mla_w_uq': nrm((lb, MLA_Q_LORA, MLA_HEADS * (MLA_NOPE_DIM + MLA_ROPE_DIM)), MLA_Q_LORA ** -0.5),
        'mla_w_ukv': nrm((lb, MLA_KV_LORA, MLA_HEADS * (MLA_NOPE_DIM + MLA_V_DIM)), MLA_KV_LORA ** -0.5),
        'mla_w_out': nrm((lb, MLA_HEADS * MLA_V_DIM, D), (MLA_HEADS * MLA_V_DIM) ** -0.5),
        'diff_w_in': nrm((lc, D, 3 * D), D ** -0.5),
        'diff_lambda': nrm((lc, 4, DIFF_HEAD_DIM), 0.1),
        'diff_subln_g': gain((lc, 2 * DIFF_HEAD_DIM)),
        'diff_w_out': nrm((lc, D, D), D ** -0.5),
        'na_w_in': nrm((ld, D, 3 * D), D ** -0.5),
        'na_rpb': nrm((ld, NA_HEADS, 2 * NA_ROWS - 1, 2 * NA_COLS - 1), 0.05),
        'na_w_out': nrm((ld, D, D), D ** -0.5),
        'final_norm_g': gain((D,)),
    }


def reference(x, c, ctx, c_ctx, ada_w, ada_b, norm1_g, norm2_g, ffn_w_up, ffn_conv_w, ffn_conv_b, ffn_w_down,
              gqa_w_in, gqa_q_norm_g, gqa_k_norm_g, gqa_w_out,
              mla_w_in, mla_q_norm_g, mla_kv_norm_g, mla_w_uq, mla_w_ukv, mla_w_out,
              diff_w_in, diff_lambda, diff_subln_g, diff_w_out,
              na_w_in, na_rpb, na_w_out, final_norm_g):
    silu_c = jax.nn.silu(c)
    silu_cc = jax.nn.silu(c_ctx)
    for i in range(DEPTH):
        ctx_out = i < DEPTH - 1
        m, j = i % N_MIXERS, i // N_MIXERS
        sh1, sc1, g1, sh2, sc2, g2 = (a[:, None, :] for a in jnp.split(silu_c @ ada_w[i] + ada_b[i], 6, axis=-1))
        csh1, csc1, cg1, csh2, csc2, cg2 = jnp.split(silu_cc @ ada_w[i] + ada_b[i], 6, axis=-1)
        hx = norm_modulate(x, norm1_g[i], sh1, sc1)
        hc = norm_modulate(ctx, norm1_g[i], csh1, csc1)
        if m == 0:
            ox, oc = gqa_mixer(hx, hc, gqa_w_in[j], gqa_q_norm_g[j], gqa_k_norm_g[j], gqa_w_out[j], ctx_out)
        elif m == 1:
            ox, oc = mla_mixer(hx, hc, mla_w_in[j], mla_q_norm_g[j], mla_kv_norm_g[j], mla_w_uq[j],
                               mla_w_ukv[j], mla_w_out[j], ctx_out)
        elif m == 2:
            ox, oc = diff_mixer(hx, hc, diff_w_in[j], diff_lambda[j], diff_subln_g[j], diff_w_out[j], i, ctx_out)
        else:
            ox, oc = na_mixer(hx, hc, na_w_in[j], na_rpb[j], na_w_out[j], ctx_out)
        x = x + g1 * ox
        x = x + g2 * conv_ffn(norm_modulate(x, norm2_g[i], sh2, sc2),
                              ffn_w_up[i], ffn_conv_w[i], ffn_conv_b[i], ffn_w_down[i])
        if ctx_out:
            ctx = ctx + cg1 * oc
            ctx = ctx + cg2 * conv_ffn(norm_modulate(ctx, norm2_g[i], csh2, csc2),
                                       ffn_w_up[i], ffn_conv_w[i], ffn_conv_b[i], ffn_w_down[i])
    return rms_norm(x, final_norm_g)
```

```cpp
#include <hip/hip_runtime.h>
#include <hip/hip_cooperative_groups.h>
#include <cstdio>
#include <cstdint>
#include <cmath>
namespace cg = cooperative_groups;

typedef _Float16 h16;
typedef _Float16 h16x8 __attribute__((ext_vector_type(8)));
typedef _Float16 h16x4 __attribute__((ext_vector_type(4)));
typedef float f32x16 __attribute__((ext_vector_type(16)));
typedef float f32x4 __attribute__((ext_vector_type(4)));
typedef float f32x2 __attribute__((ext_vector_type(2)));
typedef _Float16 h16x2 __attribute__((ext_vector_type(2)));
typedef unsigned u32x4 __attribute__((ext_vector_type(4)));

constexpr int DM = 1024, NB = 4, SEQ = 8192, NCTX = 256, SALL = 8448, NR = NB * SALL, FFN = 2816;
constexpr float EPS = 1e-6f, LOG2E = 1.4426950408889634f;
constexpr int NPH = 38;

constexpr size_t OFF_X = 0;
constexpr size_t OFF_HN = 138412032;
constexpr size_t OFF_W = 207618048;
constexpr size_t OFF_BIG = 233308160;
constexpr size_t OFF_Q = OFF_BIG, OFF_K = OFF_BIG + 103809024, OFF_VT = OFF_BIG + 207618048;
constexpr size_t OFF_MOD = 510132224;
constexpr size_t OFF_T64 = OFF_MOD + 491520;
constexpr size_t OFF_T32 = OFF_T64 + 16384;
constexpr size_t OFF_CTL = OFF_T32 + 8192;
constexpr size_t WS_END = OFF_CTL + 1024;
constexpr size_t W_UP = 0, W_DN = 5767168, W_MIX = 8650752;

struct P { const float* in[30]; float* out; unsigned char* ws; int ph_lo, ph_hi; };

#define GLD16(ptr) (*(const __attribute__((address_space(1))) u32x4*)(ptr))
#define AS1 __attribute__((address_space(1)))
#define AS3 __attribute__((address_space(3)))
#define LAUNDER_V(x) asm volatile("" : "+v"(x))
#define LAUNDER_S(x) asm volatile("" : "+s"(x))
__device__ __forceinline__ int tid_now(int wv) { unsigned z = 0u; asm volatile("" : "+v"(z)); return (wv << 6) + (int)__builtin_amdgcn_mbcnt_hi(~0u, __builtin_amdgcn_mbcnt_lo(~0u, z)); }
#define MFMA(a, b, c) __builtin_amdgcn_mfma_f32_32x32x16_f16((a), (b), (c), 0, 0, 0)
__device__ __forceinline__ int crow(int reg, int hh) { return (reg & 3) + 8 * (reg >> 2) + 4 * hh; }
template <int O> __device__ __forceinline__ float xor_swz(float v) {
  return __builtin_bit_cast(float, __builtin_amdgcn_ds_swizzle(__builtin_bit_cast(int, v), (O << 10) | 0x1f));
}
__device__ __forceinline__ float xhalf_sum(float v) {
  const unsigned u = __builtin_bit_cast(unsigned, v);
  auto rr = __builtin_amdgcn_permlane32_swap(u, u, false, false);
  return __builtin_bit_cast(float, (unsigned)rr[0]) + __builtin_bit_cast(float, (unsigned)rr[1]);
}
__device__ __forceinline__ float xhalf_max(float v) {
  const unsigned u = __builtin_bit_cast(unsigned, v);
  auto rr = __builtin_amdgcn_permlane32_swap(u, u, false, false);
  return fmaxf(__builtin_bit_cast(float, (unsigned)rr[0]), __builtin_bit_cast(float, (unsigned)rr[1]));
}
__device__ __forceinline__ float wave_sum(float v) {
  v += xor_swz<1>(v); v += xor_swz<2>(v); v += xor_swz<4>(v); v += xor_swz<8>(v); v += xor_swz<16>(v);
  return xhalf_sum(v);
}
__device__ __forceinline__ int swap23(int s) { return (s & ~12) | ((s & 4) << 1) | ((s & 8) >> 1); }
__device__ __forceinline__ float fexp2(float x) { return __builtin_amdgcn_exp2f(x); }
__device__ __forceinline__ float max3f(float a, float b, float c) { float r; asm("v_max3_f32 %0, %1, %2, %3" : "=v"(r) : "v"(a), "v"(b), "v"(c)); return r; }
__device__ __forceinline__ float rowmax32(const f32x16& a, const f32x16& b) {
  float x = max3f(a[0], a[1], b[0]), y = max3f(a[2], a[3], b[1]);
  x = max3f(x, b[2], b[3]);
#pragma unroll
  for (int e = 4; e < 16; e += 4) { x = max3f(x, a[e], a[e + 1]); y = max3f(y, a[e + 2], a[e + 3]); x = max3f(x, b[e], b[e + 1]); y = max3f(y, b[e + 2], b[e + 3]); }
  float r; asm("v_max_f32_e32 %0, %1, %2" : "=v"(r) : "v"(x), "v"(y)); return r;
}
__device__ __forceinline__ unsigned pk_h2(float a, float b) { const f32x2 v = {a, b}; return __builtin_bit_cast(unsigned, __builtin_convertvector(v, h16x2)); }

__device__ __forceinline__ void mod_item(const P& p, const int wv, int it, unsigned char* smem, const int tid) {
  unsigned char* ws = p.ws; LAUNDER_S(ws);
  const int l = it / 96, cb = it % 96;
  float* sv = (float*)smem;
  for (int i = tid; i < 5120; i += 512) {
    const int g = i >> 10, k = i & 1023;
    const float c = g < 4 ? p.in[1][g * 1024 + k] : p.in[3][k];
    sv[i] = c / (1.f + __expf(-c));
  }
  __syncthreads();
  const int kq = tid >> 6, lane = tid & 63, n = cb * 64 + lane;
  const float* w = p.in[4] + ((size_t)l * 1024 + kq * 128) * 6144 + n;
  const float* s = sv + kq * 128;
  float a0 = 0.f, a1 = 0.f, a2 = 0.f, a3 = 0.f, a4 = 0.f;
#pragma unroll 8
  for (int k = 0; k < 128; ++k) {
    const float wv = w[(size_t)k * 6144];
    a0 += s[k] * wv; a1 += s[1024 + k] * wv; a2 += s[2048 + k] * wv; a3 += s[3072 + k] * wv; a4 += s[4096 + k] * wv;
  }
  float* red = sv + 5120;
  red[(kq * 5 + 0) * 64 + lane] = a0; red[(kq * 5 + 1) * 64 + lane] = a1; red[(kq * 5 + 2) * 64 + lane] = a2;
  red[(kq * 5 + 3) * 64 + lane] = a3; red[(kq * 5 + 4) * 64 + lane] = a4;
  __syncthreads();
  float* MOD = (float*)(ws + OFF_MOD);
  for (int i = tid; i < 320; i += 512) {
    const int g = i >> 6, ln = i & 63, nn = cb * 64 + ln;
    float v = p.in[5][l * 6144 + nn];
#pragma unroll
    for (int q8 = 0; q8 < 8; ++q8) v += red[(q8 * 5 + g) * 64 + ln];
    MOD[(size_t)(l * 5 + g) * 6144 + nn] = v;
  }
  __syncthreads();
}

__device__ __forceinline__ void transpose_tile(const float* __restrict__ src, int K, int N, int Npad, h16* __restrict__ dst, int mode, int tile,
                                               unsigned char* smem, const int tid) {
  const int ntn = Npad >> 6;
  const int k0 = (tile / ntn) * 64, n0 = (tile % ntn) * 64;
  float* tl = (float*)smem;
#pragma unroll
  for (int ps = 0; ps < 2; ++ps) {
    const int k = ps * 32 + (tid >> 4), nn = n0 + (tid & 15) * 4;
    f32x4 v = {0.f, 0.f, 0.f, 0.f};
    if (nn < N) v = *(const f32x4*)(src + (size_t)(k0 + k) * N + nn);
    float* t = tl + k * 65 + (tid & 15) * 4;
    t[0] = v[0]; t[1] = v[1]; t[2] = v[2]; t[3] = v[3];
  }
  __syncthreads();
  const int n = tid >> 3, kc = (tid & 7) * 8;
  h16x8 o0;
#pragma unroll
  for (int i = 0; i < 8; ++i) o0[i] = (h16)tl[(kc + i) * 65 + n];
  const int ng = n0 + n;
  int drow = ng;
  if (mode == 1) { drow = ng < FFN ? ((ng >> 7) * 256 + (ng & 127)) : ((((ng - FFN) >> 7) * 256) + 128 + ((ng - FFN) & 127)); }
  h16* d = dst + (size_t)drow * K + k0 + kc;
  *(h16x8*)d = o0;
  __syncthreads();
}

__device__ __forceinline__ int layer_items(int l) { return 2112 + (l == 0 ? 640 : (l == 1 ? 720 : 1024)); }

__device__ __forceinline__ void convert_weights(const P& p, const int wv, int l, unsigned char* smem) {
  int tid = tid_now(wv); LAUNDER_V(tid);
  unsigned char* ws = p.ws; LAUNDER_S(ws);
  h16* W = (h16*)(ws + OFF_W);
  const int total = layer_items(l);
  for (int it = blockIdx.x; it < total; it += gridDim.x) {
    int r = it;
#define TRY(src, K, N, Npad, dst, mode) { const int nt_ = ((K) >> 6) * ((Npad) >> 6); if (r >= 0 && r < nt_) transpose_tile((src), (K), (N), (Npad), (dst), (mode), r, smem, tid); r -= nt_; }
    TRY(p.in[8] + (size_t)l * 1024 * 5632, 1024, 5632, 5632, W + W_UP, 1)
    TRY(p.in[11] + (size_t)l * 2816 * 1024, 2816, 1024, 1024, W + W_DN, 0)
    if (l == 0) {
      TRY(p.in[12], 1024, 1536, 1536, W + W_MIX, 0)
      TRY(p.in[15], 1024, 1024, 1024, W + W_MIX + 1572864, 0)
    } else if (l == 1) {
      TRY(p.in[16], 1024, 672, 768, W + W_MIX, 0)
      TRY(p.in[19], 384, 1536, 1536, W + W_MIX + 786432, 0)
      TRY(p.in[20], 256, 2048, 2048, W + W_MIX + 1376256, 0)
      TRY(p.in[21], 1024, 1024, 1024, W + W_MIX + 1900544, 0)
    } else if (l == 2) {
      TRY(p.in[22], 1024, 3072, 3072, W + W_MIX, 0)
      TRY(p.in[25], 1024, 1024, 1024, W + W_MIX + 3145728, 0)
    } else {
      TRY(p.in[26], 1024, 3072, 3072, W + W_MIX, 0)
      TRY(p.in[28], 1024, 1024, 1024, W + W_MIX + 3145728, 0)
    }
#undef TRY
  }
}

__device__ __forceinline__ void phase_prep(const P& p, const int wv, unsigned char* smem) {
  unsigned char* ws = p.ws; LAUNDER_S(ws);
  int tid = tid_now(wv); LAUNDER_V(tid);
  for (int it = blockIdx.x; it < 384; it += gridDim.x) mod_item(p, wv, it, smem, tid);
  convert_weights(p, wv, 0, smem);
  const size_t gtid = (size_t)blockIdx.x * 512 + tid, nth = (size_t)gridDim.x * 512;
  f32x4* X4 = (f32x4*)(ws + OFF_X);
  for (size_t i0 = gtid; i0 < (size_t)NR * 256; i0 += nth * 8) {
    f32x4 tv[8];
#pragma unroll
    for (int u = 0; u < 8; ++u) {
      const size_t i = i0 + (size_t)u * nth;
      if (i < (size_t)NR * 256) {
        const int row = (int)(i >> 8), c4 = (int)(i & 255);
        const int b = row / SALL, s = row - b * SALL;
        const float* src = s < NCTX ? p.in[2] + (size_t)(b * NCTX + s) * 1024 : p.in[0] + (size_t)(b * SEQ + s - NCTX) * 1024;
        tv[u] = ((const AS1 f32x4*)src)[c4];
      }
    }
#pragma unroll
    for (int u = 0; u < 8; ++u) {
      const size_t i = i0 + (size_t)u * nth;
      if (i < (size_t)NR * 256) ((AS1 f32x4*)X4)[i] = tv[u];
    }
  }
  float* T64 = (float*)(ws + OFF_T64);
  float* T32 = (float*)(ws + OFF_T32);
  for (size_t i = gtid; i < 128 * 16; i += nth) {
    const int pos = (int)(i >> 4), f = (int)(i & 15);
    const float inv = powf(10000.f, -(float)(2 * f) / 32.f);
    const float ang = (float)pos * inv;
    T64[i * 2] = cosf(ang); T64[i * 2 + 1] = sinf(ang);
  }
  for (size_t i = gtid; i < 128 * 8; i += nth) {
    const int pos = (int)(i >> 3), f = (int)(i & 7);
    const float inv = powf(10000.f, -(float)(2 * f) / 16.f);
    const float ang = (float)pos * inv;
    T32[i * 2] = cosf(ang); T32[i * 2 + 1] = sinf(ang);
  }
}

__device__ __forceinline__ void phase_modnorm(const P& p, const int wv, int l, int which) {
  unsigned char* ws = p.ws; LAUNDER_S(ws);
  int tid = tid_now(wv); LAUNDER_V(tid);
  const int lane = tid & 63, wid = tid >> 6;
  const float* X = (const float*)(ws + OFF_X);
  h16* HN = (h16*)(ws + OFF_HN);
  const float* MOD = (const float*)(ws + OFF_MOD);
  const float* g = p.in[which ? 7 : 6] + l * 1024;
  for (int row0 = (blockIdx.x * 8 + wid) * 4; row0 < NR; row0 += gridDim.x * 32) {
    const int b = row0 / SALL, s = row0 - b * SALL, grp = s < NCTX ? 4 : b;
    const float* sh = MOD + (size_t)((l * 5 + grp) * 6 + which * 3) * 1024;
    const float* sc = sh + 1024;
    f32x4 v[4][4]; float rstd[4];
#pragma unroll
    for (int u = 0; u < 4; ++u)
#pragma unroll
      for (int j = 0; j < 4; ++j) v[u][j] = *(const f32x4*)(X + (size_t)(row0 + u) * 1024 + j * 256 + lane * 4);
#pragma unroll
    for (int u = 0; u < 4; ++u) {
      float ss = 0.f;
#pragma unroll
      for (int j = 0; j < 4; ++j) ss += v[u][j][0] * v[u][j][0] + v[u][j][1] * v[u][j][1] + v[u][j][2] * v[u][j][2] + v[u][j][3] * v[u][j][3];
      rstd[u] = rsqrtf(wave_sum(ss) * (1.f / 1024.f) + EPS);
    }
#pragma unroll
    for (int j = 0; j < 4; ++j) {
      const int col = j * 256 + lane * 4;
      const f32x4 gg = *(const f32x4*)(g + col), scv = *(const f32x4*)(sc + col), shv = *(const f32x4*)(sh + col);
#pragma unroll
      for (int u = 0; u < 4; ++u) {
        h16x4 o;
#pragma unroll
        for (int i = 0; i < 4; ++i) o[i] = (h16)(v[u][j][i] * rstd[u] * gg[i] * (1.f + scv[i]) + shv[i]);
        { const int rw = row0 + u;
          *(h16x4*)(HN + ((size_t)(rw >> 8) * 16 + (col >> 6)) * 16384 + (rw & 255) * 64 + (col & 63)) = o; }
      }
    }
  }
}

__device__ __forceinline__ void phase_final(const P& p, const int wv) {
  unsigned char* ws = p.ws; LAUNDER_S(ws);
  int tid = tid_now(wv); LAUNDER_V(tid);
  const int lane = tid & 63, wid = tid >> 6;
  const float* X = (const float*)(ws + OFF_X);
  const float* g = p.in[29];
  for (int orow = blockIdx.x * 8 + wid; orow < NB * SEQ; orow += gridDim.x * 8) {
    const int b = orow / SEQ, t = orow - b * SEQ;
    const float* xr = X + (size_t)(b * SALL + NCTX + t) * 1024;
    f32x4 v[4]; float ss = 0.f;
#pragma unroll
    for (int j = 0; j < 4; ++j) { v[j] = *(const f32x4*)(xr + j * 256 + lane * 4); ss += v[j][0] * v[j][0] + v[j][1] * v[j][1] + v[j][2] * v[j][2] + v[j][3] * v[j][3]; }
    const float rstd = rsqrtf(wave_sum(ss) * (1.f / 1024.f) + EPS);
#pragma unroll
    for (int j = 0; j < 4; ++j) {
      const int col = j * 256 + lane * 4;
      const f32x4 gg = *(const f32x4*)(g + col);
      f32x4 o;
#pragma unroll
      for (int i = 0; i < 4; ++i) o[i] = v[j][i] * rstd * gg[i];
      *(f32x4*)(p.out + (size_t)orow * 1024 + col) = o;
    }
  }
}

constexpr int GSTAGE = 65536;
__device__ __forceinline__ void gemm_mainloop(const h16* __restrict__ A, int lda, const int (&arow)[4], const h16* __restrict__ Bt, int K, int n0,
                                              unsigned char* smem, f32x16 (&acc)[4][2], const int tid, const int kt0 = 0, const int nkt = -1, const bool a_tiled = false) {
  const int lane = tid & 63, wid = tid >> 6, wm = wid >> 2, wn = wid & 3, r = lane & 31, hh = lane >> 5;
  const int lrow = tid >> 3, lc = tid & 7;
  const char* Ab = (const char*)A; const char* Bb = (const char*)(Bt + (size_t)n0 * K);
  unsigned ao[4], bo[4];
#pragma unroll
  for (int j = 0; j < 4; ++j) { const int row = lrow + 64 * j; const unsigned cs = (unsigned)((lc ^ ((row >> 1) & 7)) * 16);
    const unsigned ar = (unsigned)(arow[j] < 0 ? 0 : arow[j]);
    ao[j] = a_tiled ? ((ar >> 8) * (unsigned)(K >> 6) * 32768u + (ar & 255u) * 128u + cs) : (ar * (unsigned)(lda * 2) + cs);
    bo[j] = (unsigned)row * (unsigned)(K * 2) + cs; }
  const size_t akstep = a_tiled ? 32768 : 128;
  const int wbase = __builtin_amdgcn_readfirstlane(wid * 1024);
#define GLDS(k, bf) { const char* Ak_ = Ab + (size_t)(k) * akstep; const char* Bk_ = Bb + (size_t)(k) * 128; unsigned char* sb_ = smem + (bf) * GSTAGE + wbase; \
      _Pragma("unroll") for (int j = 0; j < 4; ++j) __builtin_amdgcn_global_load_lds((const AS1 unsigned*)(Ak_ + ao[j]), (AS3 unsigned*)(sb_ + j * 8192), 16, 0, 0); \
      _Pragma("unroll") for (int j = 0; j < 4; ++j) __builtin_amdgcn_global_load_lds((const AS1 unsigned*)(Bk_ + bo[j]), (AS3 unsigned*)(sb_ + 32768 + j * 8192), 16, 0, 0); }
#pragma unroll
  for (int i = 0; i < 4; ++i)
#pragma unroll
    for (int j = 0; j < 2; ++j)
#pragma unroll
      for (int e = 0; e < 16; ++e) acc[i][j][e] = 0.f;
  const int swr = (r >> 1) & 7;
  const unsigned lds0 = (unsigned)(uintptr_t)smem;
  unsigned fao[4], fbo[4];
#pragma unroll
  for (int s = 0; s < 4; ++s) { const unsigned co = (unsigned)(((2 * s + hh) ^ swr) << 4);
    fao[s] = lds0 + (wm * 128 + r) * 128 + co; fbo[s] = lds0 + 32768 + (wn * 64 + r) * 128 + co; }
#define FRD(dst, addr, imm) asm volatile("ds_read_b128 %0, %1 offset:%2" : "=v"(dst) : "v"(addr), "i"(imm))
#define FISSUE(FA, FB, s, bofs) { FRD(FA[0], fao[s] + (bofs), 0); FRD(FA[1], fao[s] + (bofs), 4096); FRD(FA[2], fao[s] + (bofs), 8192); FRD(FA[3], fao[s] + (bofs), 12288); \
                                  FRD(FB[0], fbo[s] + (bofs), 0); FRD(FB[1], fbo[s] + (bofs), 4096); }
#define FWAIT(FA, FB, n) asm volatile("s_waitcnt lgkmcnt(" #n ")" : "+v"(FA[0]), "+v"(FA[1]), "+v"(FA[2]), "+v"(FA[3]), "+v"(FB[0]), "+v"(FB[1]))
#define FMMA(FA, FB) { _Pragma("unroll") for (int mt = 0; mt < 4; ++mt) _Pragma("unroll") for (int nt = 0; nt < 2; ++nt) acc[mt][nt] = MFMA(FA[mt], FB[nt], acc[mt][nt]); }
  const int nk = nkt < 0 ? (K >> 6) : nkt;
  const int kend = kt0 + nk;
  int kk = kt0 + (nkt < 0 ? (((int)(blockIdx.x >> 3) * nk) >> 5) : 0);
  GLDS(kk, 0)
  __syncthreads();
  for (int kt = 0; kt < nk; ++kt) {
    const unsigned bofs = (unsigned)((kt & 1) * GSTAGE);
    kk = (kk + 1 == kend) ? kt0 : kk + 1;
    if (kt + 1 < nk) GLDS(kk, (kt & 1) ^ 1)
    asm volatile("" ::: "memory");
    h16x8 fa0[4], fb0[2], fa1[4], fb1[2];
    FISSUE(fa0, fb0, 0, bofs)
    FISSUE(fa1, fb1, 1, bofs)
    FWAIT(fa0, fb0, 6); FMMA(fa0, fb0)
    FISSUE(fa0, fb0, 2, bofs)
    FWAIT(fa1, fb1, 6); FMMA(fa1, fb1)
    FISSUE(fa1, fb1, 3, bofs)
    FWAIT(fa0, fb0, 6); FMMA(fa0, fb0)
    FWAIT(fa1, fb1, 0); FMMA(fa1, fb1)
    asm volatile("" ::: "memory");
    __syncthreads();
  }
#undef GLDS
#undef FRD
#undef FISSUE
#undef FWAIT
#undef FMMA
}

__device__ __forceinline__ int tile_u(int step) {
  const int b = blockIdx.x, g8 = gridDim.x >> 3;
  return (step * 8 + (b & 7)) * g8 + (b >> 3);
}
__device__ __forceinline__ void tile_band(int u, int NTn, int& mt, int& nt) {
  const int bandsz = 4 * NTn, band = u / bandsz, w = u - band * bandsz;
  mt = band * 4 + (w & 3); nt = w >> 2;
}
constexpr int SPITCH = 264;
__device__ __forceinline__ void stage_acc(const f32x16 (&acc)[4][2], unsigned char* smem, const int tid) {
  const int lane = tid & 63, wid = tid >> 6, wm = wid >> 2, wn = wid & 3, r = lane & 31, hh = lane >> 5;
  h16* st = (h16*)smem;
#pragma unroll
  for (int mt = 0; mt < 4; ++mt)
#pragma unroll
    for (int nt = 0; nt < 2; ++nt)
#pragma unroll
      for (int e = 0; e < 16; ++e) st[(wm * 128 + mt * 32 + crow(e, hh)) * SPITCH + wn * 64 + nt * 32 + r] = (h16)acc[mt][nt][e];
  __syncthreads();
}

__device__ __forceinline__ void phase_gemm_resid(const P& p, const int wv, int l, const h16* A, int K, const h16* Bt, int gidx, bool ctx_out, unsigned char* smem) {
  unsigned char* ws = p.ws; LAUNDER_S(ws);
  const int tid0 = tid_now(wv);
  float* X = (float*)(ws + OFF_X);
  const float* MOD = (const float*)(ws + OFF_MOD);
  for (int step = 0; step * (int)gridDim.x < 512; ++step) {
    const int t = tile_u(step);
    if (t >= 512) continue;
    int tid = tid_now(wv);
    const int lane = tid & 63, wid = tid >> 6, wm = wid >> 2, wn = wid & 3, r = lane & 31, hh = lane >> 5;
    int lm, nt_g; tile_band(t, 4, lm, nt_g);
    const int mt_g = (lm >> 5) * 33 + 1 + (lm & 31);
    const int bb = mt_g / 33;
    int arow[4];
#pragma unroll
    for (int j = 0; j < 4; ++j) arow[j] = mt_g * 256 + (tid >> 3) + 64 * j;
    f32x16 acc[4][2];
    gemm_mainloop(A, K, arow, Bt, K, nt_g * 256, smem, acc, tid);
    const float* gate = MOD + (size_t)((l * 5 + bb) * 6 + gidx) * 1024;
#pragma unroll
    for (int nt = 0; nt < 2; ++nt) {
      const int n = nt_g * 256 + wn * 64 + nt * 32 + r;
      const float gv = gate[n];
#pragma unroll
      for (int mt = 0; mt < 4; ++mt) {
        AS1 float* base = (AS1 float*)(X + (size_t)(mt_g * 256 + wm * 128 + mt * 32 + 4 * hh) * 1024 + n);
        float xv[16];
#pragma unroll
        for (int e = 0; e < 16; ++e) xv[e] = base[((e & 3) + 8 * (e >> 2)) * 1024];
#pragma unroll
        for (int e = 0; e < 16; ++e) base[((e & 3) + 8 * (e >> 2)) * 1024] = xv[e] + gv * acc[mt][nt][e];
      }
    }
  }
  if (ctx_out) {
    for (int step = 0; step * (int)gridDim.x < 256; ++step) {
      const int c = tile_u(step);
      if (c >= 256) continue;
      int tid = tid_now(wv);
      const int lane = tid & 63, wid = tid >> 6, wm = wid >> 2, wn = wid & 3, r = lane & 31, hh = lane >> 5;
      const int ct = c >> 4, ks = c & 15, nkf = K >> 6;
      const int nt_g = ct & 3, mt_g = (ct >> 2) * 33;
      const int kt0 = (ks * nkf) >> 4, nkt = (((ks + 1) * nkf) >> 4) - kt0;
      int arow[4];
#pragma unroll
      for (int j = 0; j < 4; ++j) arow[j] = mt_g * 256 + (tid >> 3) + 64 * j;
      f32x16 acc[4][2];
      gemm_mainloop(A, K, arow, Bt, K, nt_g * 256, smem, acc, tid, kt0, nkt);
      const float* gate = MOD + (size_t)((l * 5 + 4) * 6 + gidx) * 1024;
#pragma unroll
      for (int nt = 0; nt < 2; ++nt) {
        const int n = nt_g * 256 + wn * 64 + nt * 32 + r;
        const float gv = gate[n];
#pragma unroll
        for (int mt = 0; mt < 4; ++mt)
#pragma unroll
          for (int e = 0; e < 16; ++e) {
            float* px = X + (size_t)(mt_g * 256 + wm * 128 + mt * 32 + crow(e, hh)) * 1024 + n;
            unsafeAtomicAdd(px, gv * acc[mt][nt][e]);
          }
      }
    }
  }
}

__device__ __forceinline__ void seg_read(const unsigned char* smem, int trow, int col0, float (&v)[64]) {
  const h16* st = (const h16*)smem + trow * SPITCH + col0;
#pragma unroll
  for (int c = 0; c < 8; ++c) {
    const h16x8 x = *(const h16x8*)(st + c * 8);
#pragma unroll
    for (int i = 0; i < 8; ++i) v[c * 8 + i] = (float)x[i];
  }
}
__device__ __forceinline__ void seg_rope64(const float* T64, int s, float (&v)[64]) {
  if (s < NCTX) return;
  const int t = s - NCTX, prow = t >> 6, pcol = t & 63;
  const AS1 f32x4* tr = (const AS1 f32x4*)((const f32x2*)T64 + prow * 16);
  const AS1 f32x4* tc = (const AS1 f32x4*)((const f32x2*)T64 + pcol * 16);
  f32x4 ta[8], tb[8];
#pragma unroll
  for (int f = 0; f < 8; ++f) { ta[f] = tr[f]; tb[f] = tc[f]; }
#pragma unroll
  for (int f = 0; f < 16; ++f) {
    const f32x2 a = {ta[f >> 1][(f & 1) * 2], ta[f >> 1][(f & 1) * 2 + 1]}, c = {tb[f >> 1][(f & 1) * 2], tb[f >> 1][(f & 1) * 2 + 1]};
    const float x1 = v[f], x2 = v[16 + f], x3 = v[32 + f], x4 = v[48 + f];
    v[f] = x1 * a[0] - x2 * a[1]; v[16 + f] = x2 * a[0] + x1 * a[1];
    v[32 + f] = x3 * c[0] - x4 * c[1]; v[48 + f] = x4 * c[0] + x3 * c[1];
  }
}
__device__ __forceinline__ void seg_store_row(h16* dst, const float (&v)[64], float scale) {
#pragma unroll
  for (int c = 0; c < 8; ++c) {
    h16x8 o;
#pragma unroll
    for (int i = 0; i < 8; ++i) o[i] = (h16)(v[c * 8 + i] * scale);
    *(h16x8*)(dst + c * 8) = o;
  }
}
__device__ __forceinline__ void seg_store_vt(h16* dst  , const float (&v)[64]) {
#pragma unroll
  for (int d = 0; d < 64; ++d) dst[(size_t)d * SALL] = (h16)v[d];
}

__device__ __forceinline__ void phase_gemm_inproj(const P& p, const int wv, int mixer, unsigned char* smem) {
  unsigned char* ws = p.ws; LAUNDER_S(ws);
  const int tid0 = tid_now(wv);
  const h16* HN = (const h16*)(ws + OFF_HN);
  const h16* Wt = (const h16*)(ws + OFF_W) + W_MIX;
  h16* Qb = (h16*)(ws + OFF_Q); h16* Kb = (h16*)(ws + OFF_K); h16* Vt = (h16*)(ws + OFF_VT);
  const float* T64 = (const float*)(ws + OFF_T64);
  const int NT = mixer == 0 ? 6 : 12;
  const int ntiles = 132 * NT;
  const float qscale = 0.125f * LOG2E;
  for (int step = 0; step * (int)gridDim.x < ntiles; ++step) {
    const int t = tile_u(step);
    if (t >= ntiles) continue;
    int tid = tid_now(wv);
    int mt_g, nt_g;
    if (t < 128 * NT) { int lm; tile_band(t, NT, lm, nt_g); mt_g = (lm >> 5) * 33 + 1 + (lm & 31); }
    else { int cm; tile_band(t - 128 * NT, NT, cm, nt_g); mt_g = cm * 33; }
    int arow[4];
#pragma unroll
    for (int j = 0; j < 4; ++j) arow[j] = mt_g * 256 + (tid >> 3) + 64 * j;
    f32x16 acc[4][2];
    gemm_mainloop(HN, 1024, arow, Wt, 1024, nt_g * 256, smem, acc, tid, 0, -1, true);
    stage_acc(acc, smem, tid);
    const int trow = tid & 255, sh = tid >> 8;
    const int grow = mt_g * 256 + trow;
    const int b = grow / SALL, s = grow - b * SALL;
#pragma unroll 1
    for (int sg = 0; sg < 2; ++sg) {
      const int seg = sh * 2 + sg;
      const int col0 = nt_g * 256 + seg * 64;
      float v[64];
      seg_read(smem, trow, seg * 64, v);
      if (mixer == 0) {
        if (col0 < 1280) {
          const bool isq = col0 < 1024;
          const float* g = isq ? p.in[13] : p.in[14];
          float ss = 0.f;
#pragma unroll
          for (int d = 0; d < 64; ++d) ss += v[d] * v[d];
          const float rstd = rsqrtf(ss * (1.f / 64.f) + EPS);
#pragma unroll
          for (int d = 0; d < 64; ++d) v[d] = v[d] * rstd * g[d];
          seg_rope64(T64, s, v);
          if (isq) seg_store_row(Qb + ((size_t)(b * 16 + (col0 >> 6)) * SALL + s) * 64, v, qscale);
          else seg_store_row(Kb + ((size_t)(b * 4 + ((col0 - 1024) >> 6)) * SALL + s) * 64, v, 1.f);
        } else {
          seg_store_vt(Vt + (size_t)(b * 4 + ((col0 - 1280) >> 6)) * 64 * SALL + swap23(s), v);
        }
      } else if (mixer == 2) {
        if (col0 < 2048) {
          seg_rope64(T64, s, v);
          if (col0 < 1024) seg_store_row(Qb + ((size_t)(b * 16 + (col0 >> 6)) * SALL + s) * 64, v, qscale);
          else seg_store_row(Kb + ((size_t)(b * 16 + ((col0 - 1024) >> 6)) * SALL + s) * 64, v, 1.f);
        } else {
          const int c = col0 - 2048;
          seg_store_vt(Vt + ((size_t)(b * 8 + (c >> 7)) * 128 + (c & 127)) * SALL + swap23(s), v);
        }
      } else {
        if (col0 < 1024) seg_store_row(Qb + ((size_t)(b * 16 + (col0 >> 6)) * SALL + s) * 64, v, qscale);
        else if (col0 < 2048) seg_store_row(Kb + ((size_t)(b * 16 + ((col0 - 1024) >> 6)) * SALL + s) * 64, v, 1.f);
        else seg_store_vt(Vt + (size_t)(b * 16 + ((col0 - 2048) >> 6)) * 64 * SALL + swap23(s), v);
      }
    }
    __syncthreads();
  }
}

__device__ __forceinline__ void phase_gemm_mla1(const P& p, const int wv, unsigned char* smem) {
  unsigned char* ws = p.ws; LAUNDER_S(ws);
  const int tid0 = tid_now(wv);
  const h16* HN = (const h16*)(ws + OFF_HN);
  const h16* Wt = (const h16*)(ws + OFF_W) + W_MIX;
  h16* C1 = (h16*)(ws + OFF_VT);
  const int ntiles = 132 * 3;
  for (int step = 0; step * (int)gridDim.x < ntiles; ++step) {
    const int t = tile_u(step);
    if (t >= ntiles) continue;
    int tid = tid_now(wv);
    const int lane = tid & 63, wid = tid >> 6, wm = wid >> 2, wn = wid & 3, r = lane & 31, hh = lane >> 5;
    int mt_g, nt_g;
    tile_band(t, 3, mt_g, nt_g);
    int arow[4];
#pragma unroll
    for (int j = 0; j < 4; ++j) arow[j] = mt_g * 256 + (tid >> 3) + 64 * j;
    f32x16 acc[4][2];
    gemm_mainloop(HN, 1024, arow, Wt, 1024, nt_g * 256, smem, acc, tid, 0, -1, true);
#pragma unroll
    for (int mt = 0; mt < 4; ++mt)
#pragma unroll
      for (int nt = 0; nt < 2; ++nt)
#pragma unroll
        for (int e = 0; e < 16; ++e)
          C1[(size_t)(mt_g * 256 + wm * 128 + mt * 32 + crow(e, hh)) * 768 + nt_g * 256 + wn * 64 + nt * 32 + r] = (h16)acc[mt][nt][e];
  }
}

__device__ __forceinline__ void phase_mla_rownorm(const P& p, const int wv) {
  unsigned char* ws = p.ws; LAUNDER_S(ws);
  int tid = tid_now(wv); LAUNDER_V(tid);
  const int lane = tid & 63, wid = tid >> 6;
  const h16* C1 = (const h16*)(ws + OFF_VT);
  h16* CQN = (h16*)(ws + OFF_HN);
  h16* CKVN = CQN + (size_t)NR * 384;
  h16* Kb = (h16*)(ws + OFF_K);
  const float* T32 = (const float*)(ws + OFF_T32);
  const float* gq = p.in[17]; const float* gkv = p.in[18];
  for (int row = blockIdx.x * 8 + wid; row < NR; row += gridDim.x * 8) {
    const int b = row / SALL, s = row - b * SALL;
    const h16* c = C1 + (size_t)row * 768;
    {
      float v[8]; float ss = 0.f;
      if (lane < 48) { const h16x8 x = *(const h16x8*)(c + lane * 8);
#pragma unroll
        for (int i = 0; i < 8; ++i) { v[i] = (float)x[i]; ss += v[i] * v[i]; } }
      else {
#pragma unroll
        for (int i = 0; i < 8; ++i) v[i] = 0.f; }
      const float rstd = rsqrtf(wave_sum(ss) * (1.f / 384.f) + EPS);
      if (lane < 48) { h16x8 o;
#pragma unroll
        for (int i = 0; i < 8; ++i) o[i] = (h16)(v[i] * rstd * gq[lane * 8 + i]);
        *(h16x8*)(CQN + (size_t)row * 384 + lane * 8) = o; }
    }
    {
      float v[8]; float ss = 0.f;
      if (lane < 32) { const h16x8 x = *(const h16x8*)(c + 384 + lane * 8);
#pragma unroll
        for (int i = 0; i < 8; ++i) { v[i] = (float)x[i]; ss += v[i] * v[i]; } }
      else {
#pragma unroll
        for (int i = 0; i < 8; ++i) v[i] = 0.f; }
      const float rstd = rsqrtf(wave_sum(ss) * (1.f / 256.f) + EPS);
      if (lane < 32) { h16x8 o;
#pragma unroll
        for (int i = 0; i < 8; ++i) o[i] = (h16)(v[i] * rstd * gkv[lane * 8 + i]);
        *(h16x8*)(CKVN + (size_t)row * 256 + lane * 8) = o; }
    }
    {
      const int part = lane & 3, head = lane >> 2;
      const h16x8 x = *(const h16x8*)(c + 640 + part * 8);
      float v[8], w[8];
#pragma unroll
      for (int i = 0; i < 8; ++i) { v[i] = (float)x[i]; w[i] = xor_swz<1>(v[i]); }
      if (s >= NCTX) {
        const int t = s - NCTX; const int pos = (part < 2) ? (t >> 6) : (t & 63);
        const f32x2* tb = (const f32x2*)T32 + pos * 8;
#pragma unroll
        for (int i = 0; i < 8; ++i) { const f32x2 cs = tb[i];
          v[i] = (part & 1) ? (v[i] * cs[0] + w[i] * cs[1]) : (v[i] * cs[0] - w[i] * cs[1]); }
      }
      h16x8 o;
#pragma unroll
      for (int i = 0; i < 8; ++i) o[i] = (h16)v[i];
      *(h16x8*)(Kb + ((size_t)(b * 16 + head) * SALL + s) * 96 + 64 + part * 8) = o;
    }
  }
}

__device__ __forceinline__ void phase_gemm_mla2(const P& p, const int wv, unsigned char* smem) {
  unsigned char* ws = p.ws; LAUNDER_S(ws);
  const int tid0 = tid_now(wv);
  const h16* CQN = (const h16*)(ws + OFF_HN);
  const h16* CKVN = CQN + (size_t)NR * 384;
  const h16* Wuq = (const h16*)(ws + OFF_W) + W_MIX + 786432;
  const h16* Wukv = (const h16*)(ws + OFF_W) + W_MIX + 1376256;
  h16* Qb = (h16*)(ws + OFF_Q); h16* Kb = (h16*)(ws + OFF_K); h16* Vt = (h16*)(ws + OFF_VT);
  const float* T32 = (const float*)(ws + OFF_T32);
  const float qscale = 0.10206207261596577f * LOG2E;
  const int ntiles = 132 * 14;
  for (int step = 0; step * (int)gridDim.x < ntiles; ++step) {
    const int t = tile_u(step);
    if (t >= ntiles) continue;
    int tid = tid_now(wv);
    int mt_g, nn;
    if (t < 128 * 14) { int lm; tile_band(t, 14, lm, nn); mt_g = (lm >> 5) * 33 + 1 + (lm & 31); }
    else { int cm; tile_band(t - 128 * 14, 14, cm, nn); mt_g = cm * 33; }
    int arow[4];
#pragma unroll
    for (int j = 0; j < 4; ++j) arow[j] = mt_g * 256 + (tid >> 3) + 64 * j;
    f32x16 acc[4][2];
    const int trow = tid & 255, sh = tid >> 8;
    const int grow = mt_g * 256 + trow;
    const int b = grow / SALL, s = grow - b * SALL;
    if (nn < 6) {
      gemm_mainloop(CQN, 384, arow, Wuq, 384, nn * 256, smem, acc, tid);
      stage_acc(acc, smem, tid);
      const h16* st = (const h16*)smem + trow * SPITCH;
#pragma unroll 1
      for (int i2 = 0; i2 < 16; ++i2) {
        const int i = sh * 16 + i2;
        const int c0 = nn * 256 + i * 8, head = c0 / 96, dd = c0 - head * 96;
        h16* dst = Qb + ((size_t)(b * 16 + head) * SALL + s) * 96 + dd;
        if (dd < 64) {
          const h16x8 x = *(const h16x8*)(st + i * 8); h16x8 o;
#pragma unroll
          for (int e = 0; e < 8; ++e) o[e] = (h16)((float)x[e] * qscale);
          *(h16x8*)dst = o;
        } else if (dd == 64) {
          float v[32];
#pragma unroll
          for (int c = 0; c < 4; ++c) { const h16x8 x = *(const h16x8*)(st + (i + c) * 8);
#pragma unroll
            for (int e = 0; e < 8; ++e) v[c * 8 + e] = (float)x[e]; }
          if (s >= NCTX) {
            const int tt = s - NCTX;
            const f32x2* tr = (const f32x2*)T32 + (tt >> 6) * 8;
            const f32x2* tc = (const f32x2*)T32 + (tt & 63) * 8;
#pragma unroll
            for (int f = 0; f < 8; ++f) {
              const f32x2 a = tr[f], c = tc[f];
              const float x1 = v[f], x2 = v[8 + f], x3 = v[16 + f], x4 = v[24 + f];
              v[f] = x1 * a[0] - x2 * a[1]; v[8 + f] = x2 * a[0] + x1 * a[1];
              v[16 + f] = x3 * c[0] - x4 * c[1]; v[24 + f] = x4 * c[0] + x3 * c[1];
            }
          }
#pragma unroll
          for (int c = 0; c < 4; ++c) { h16x8 o;
#pragma unroll
            for (int e = 0; e < 8; ++e) o[e] = (h16)(v[c * 8 + e] * qscale);
            *(h16x8*)(dst + c * 8) = o; }
        }
      }
    } else {
      gemm_mainloop(CKVN, 256, arow, Wukv, 256, (nn - 6) * 256, smem, acc, tid);
      stage_acc(acc, smem, tid);
      {
        const int head = (nn - 6) * 2 + sh;
        const h16* st = (const h16*)smem + trow * SPITCH + sh * 128;
        h16* dst = Kb + ((size_t)(b * 16 + head) * SALL + s) * 96;
#pragma unroll
        for (int c = 0; c < 8; ++c) *(h16x8*)(dst + c * 8) = *(const h16x8*)(st + c * 8);
        h16* vd = Vt + (size_t)(b * 16 + head) * 64 * SALL + swap23(s);
#pragma unroll
        for (int c = 0; c < 8; ++c) { const h16x8 x = *(const h16x8*)(st + 64 + c * 8);
#pragma unroll
          for (int e = 0; e < 8; ++e) vd[(size_t)(c * 8 + e) * SALL] = x[e]; }
      }
    }
    __syncthreads();
  }
}

__device__ __forceinline__ void phase_gemm_ffnup(const P& p, const int wv, int l, bool ctx_out, unsigned char* smem) {
  unsigned char* ws = p.ws; LAUNDER_S(ws);
  const int tid0 = tid_now(wv);
  const h16* HN = (const h16*)(ws + OFF_HN);
  const h16* Wt = (const h16*)(ws + OFF_W) + W_UP;
  h16* ACT = (h16*)(ws + OFF_BIG);
  const float* cw = p.in[9] + (size_t)l * 3 * 5632;
  const float* cb = p.in[10] + (size_t)l * 5632;
  const int ntiles = 136 * 22;
  for (int step = 0; step * (int)gridDim.x < ntiles; ++step) {
    const int t = tile_u(step);
    if (t >= ntiles) continue;
    int tid = tid_now(wv);
    int mt_g, jt;
    if (t < 132 * 22) { int lm; tile_band(t, 22, lm, jt); mt_g = (lm / 33) * 34 + 1 + (lm % 33); }
    else { int cm; tile_band(t - 132 * 22, 22, cm, jt); mt_g = cm * 34; }
    const int b = mt_g / 34, ti0 = mt_g - b * 34;
    const bool isctx = ti0 == 0;
    if (isctx && !ctx_out) continue;
    const int ti = isctx ? 0 : ti0 - 1;
    const int len = isctx ? NCTX : SEQ;
    const int rowbase = b * SALL + (isctx ? 0 : NCTX);
    const int p0 = isctx ? 0 : 254 * ti - 1;
    int arow[4];
#pragma unroll
    for (int j = 0; j < 4; ++j) { const int pp = p0 + (tid >> 3) + 64 * j; arow[j] = (pp >= 0 && pp < len) ? rowbase + pp : -1; }
    f32x16 acc[4][2];
    gemm_mainloop(HN, 1024, arow, Wt, 1024, jt * 256, smem, acc, tid, 0, -1, true);
    stage_acc(acc, smem, tid);
    const int jc = tid & 15, rbase = tid >> 4;
    const int cv = jt * 128 + jc * 8, cg_ = FFN + cv;
    h16x8 w0v, w1v, w2v, bv, w0g, w1g, w2g, bg;
#pragma unroll
    for (int i = 0; i < 8; ++i) {
      w0v[i] = (h16)cw[cv + i]; w1v[i] = (h16)cw[5632 + cv + i]; w2v[i] = (h16)cw[2 * 5632 + cv + i]; bv[i] = (h16)cb[cv + i];
      w0g[i] = (h16)cw[cg_ + i]; w1g[i] = (h16)cw[5632 + cg_ + i]; w2g[i] = (h16)cw[2 * 5632 + cg_ + i]; bg[i] = (h16)cb[cg_ + i];
    }
    const h16* st = (const h16*)smem;
    const int lo = isctx ? 0 : 1, hi = isctx ? 255 : 254;
#pragma unroll 1
    for (int it = 0; it < 8; ++it) {
      const int sr = rbase + 32 * it;
      const int pp = p0 + sr;
      if (sr >= lo && sr <= hi && pp < len) {
        const h16* r1 = st + sr * SPITCH + jc * 8;
        h16x8 va, vc, ga, gc;
#pragma unroll
        for (int i = 0; i < 8; ++i) { va[i] = (h16)0.f; vc[i] = (h16)0.f; ga[i] = (h16)0.f; gc[i] = (h16)0.f; }
        if (sr > 0 && pp > 0) { va = *(const h16x8*)(r1 - SPITCH); ga = *(const h16x8*)(r1 - SPITCH + 128); }
        if (sr < 255 && pp + 1 < len) { vc = *(const h16x8*)(r1 + SPITCH); gc = *(const h16x8*)(r1 + SPITCH + 128); }
        const h16x8 vb = *(const h16x8*)r1, gb = *(const h16x8*)(r1 + 128);
        const h16x8 uv = va * w0v + vb * w1v + vc * w2v + bv;
        const h16x8 ug = ga * w0g + gb * w1g + gc * w2g + bg;
        const h16x8 tt = ug * uv;
        h16x8 sg;
#pragma unroll
        for (int i = 0; i < 8; ++i) sg[i] = (h16)__builtin_amdgcn_rcpf(1.f + __expf(-(float)ug[i]));
        const h16x8 o = tt * sg;
        *(h16x8*)(ACT + (size_t)(rowbase + pp) * FFN + cv) = o;
      }
    }
    __syncthreads();
  }
}

template <int DQK, int DV, int MODE, int NJ>
__device__ __forceinline__ void attn_item(const h16* __restrict__ Qb, const h16* __restrict__ Kb, const h16* __restrict__ Vtb, h16* __restrict__ O,
                                          int HQ, int HK, int HV, int KDIV, int VDIV, int b, int h, int qt, const float* rpb_h, float lam,
                                          const float* subg, float post, unsigned char* smem, const int tid) {
  constexpr int KROW = (DQK == 64) ? 128 : 256;
  constexpr int KT_BYTES = 64 * KROW, VT_BYTES = DV * 128, BUF = KT_BYTES + VT_BYTES;
  constexpr int KCH = 64 * (DQK / 8);
  constexpr int NKC = (KCH + 511) / 512;
  constexpr int NVC = DV * 8 / 512;
  constexpr int NDT = DV / 32, NS = DQK / 16;
  constexpr int OP = DV + 8;
  const int lane = tid & 63, wid = tid >> 6, r = lane & 31, hh = lane >> 5;
  const bool ctxq = qt == 0;
  const int q0 = qt * 256;
  int ntiles = ctxq ? 4 : 132;
  const int rot = ctxq ? 0 : (((qt - 1) & 31) * 33) >> 3;
  int bs = 0, rq = 0, qcol = 0, rsq = 0, cs = 0;
  float* rpbL = (float*)(smem + 49152);
  if (MODE == 1) {
    if (!ctxq) {
      const int r0 = 4 * (qt - 1);
      bs = min(max(r0 - 4, 0), 120);
      const int be = min(max(r0 + 3 - 4, 0), 120) + 8;
      ntiles = 4 + (be - bs);
      rq = r0 + (wid >> 1); qcol = (wid & 1) * 32 + r;
      rsq = min(max(rq - 4, 0), 120); cs = min(max(qcol - 8, 0), 48);
    }
    __syncthreads();
    for (int i = tid; i < 465; i += 512) rpbL[i] = rpb_h[i] * LOG2E;
  }
  const unsigned lds0 = (unsigned)(uintptr_t)smem;
  unsigned koff[NS], voff[4];
#pragma unroll
  for (int s = 0; s < NS; ++s) { const int c = 2 * s + hh;
    koff[s] = lds0 + ((DQK == 64) ? (r * 128 + ((c ^ ((r >> 1) & 7)) << 4)) : (r * 256 + ((c ^ (r & 15)) << 4))); }
#pragma unroll
  for (int s = 0; s < 4; ++s) { const int c = 2 * s + hh; voff[s] = lds0 + KT_BYTES + r * 128 + ((c ^ ((r >> 1) & 7)) << 4); }
#define DSR(dst, addr, imm) asm volatile("ds_read_b128 %0, %1 offset:%2" : "=v"(dst) : "v"(addr), "i"(imm))
#define WAIT8(f) asm volatile("s_waitcnt lgkmcnt(0)" : "+v"(f[0]), "+v"(f[1]), "+v"(f[2]), "+v"(f[3]), "+v"(f[4]), "+v"(f[5]), "+v"(f[6]), "+v"(f[7]))
#pragma unroll 1
  for (int jj = 0; jj < NJ; ++jj) {
    const int hq = (NJ == 2) ? 2 * h + jj : h;
    const h16* Qp = Qb + ((size_t)(b * HQ + hq) * SALL + q0 + wid * 32 + r) * DQK + hh * 8;
    const h16* Kp = Kb + (size_t)(b * HK + hq / KDIV) * SALL * DQK;
    const h16* Vp = Vtb + (size_t)(b * HV + hq / VDIV) * DV * SALL;
    h16x8 qf[NS];
#pragma unroll
    for (int s = 0; s < NS; ++s) qf[s] = __builtin_bit_cast(h16x8, GLD16(Qp + s * 16));
    f32x16 o[NDT];
#pragma unroll
    for (int dt = 0; dt < NDT; ++dt)
#pragma unroll
      for (int e = 0; e < 16; ++e) o[dt][e] = 0.f;
    float m = 0.f, lsum = 0.f;
    f32x16 negm;
#pragma unroll
    for (int e = 0; e < 16; ++e) negm[e] = 0.f;
    u32x4 rk[NKC], rv[NVC];
#define KV0(t) ((MODE == 1) ? ((!ctxq && (t) >= 4) ? (NCTX + (bs + (t) - 4) * 64) : ((t) * 64)) : ((((t) + rot) >= ntiles ? ((t) + rot - ntiles) : ((t) + rot)) * 64))
#define TLOAD(t) { const int kv0_ = KV0(t); \
      _Pragma("unroll") for (int i = 0; i < NKC; ++i) { const int ci = tid + 512 * i; if (ci < KCH) rk[i] = GLD16(Kp + (size_t)kv0_ * DQK + ci * 8); } \
      _Pragma("unroll") for (int i = 0; i < NVC; ++i) { const int ci = tid + 512 * i; rv[i] = GLD16(Vp + (size_t)(ci >> 3) * SALL + kv0_ + (ci & 7) * 8); } }
#define TWRITE(bf) { unsigned char* kb_ = smem + (bf) * BUF; \
      _Pragma("unroll") for (int i = 0; i < NKC; ++i) { const int ci = tid + 512 * i; if (ci < KCH) { \
        if (DQK == 64) { const int row = ci >> 3, c = ci & 7; *(u32x4*)(kb_ + row * 128 + ((c ^ ((row >> 1) & 7)) << 4)) = rk[i]; } \
        else { const int row = ci / 12, c = ci - row * 12; *(u32x4*)(kb_ + row * 256 + ((c ^ (row & 15)) << 4)) = rk[i]; } } } \
      _Pragma("unroll") for (int i = 0; i < NVC; ++i) { const int ci = tid + 512 * i; const int d = ci >> 3, c = ci & 7; \
        *(u32x4*)(kb_ + KT_BYTES + d * 128 + ((c ^ ((d >> 1) & 7)) << 4)) = rv[i]; } }
    TLOAD(0)
    __syncthreads();
    TWRITE(0)
    __syncthreads();
    for (int t = 0; t < ntiles; ++t) {
      const int buf = t & 1;
      if (t + 1 < ntiles) TLOAD(t + 1)
      bool active = true; int krow = 0;
      if (MODE == 1 && !ctxq && t >= 4) { krow = bs + t - 4; active = (krow >= rsq) && (krow < rsq + 8); }
      if (active) {
        const unsigned char* kb = smem + buf * BUF;
        const unsigned char* vb = kb + KT_BYTES;
        f32x16 p0, p1;
        const unsigned bofs = (unsigned)(buf * BUF);
        {
          h16x8 kf[2 * NS];
#pragma unroll
          for (int s = 0; s < NS; ++s) { DSR(kf[2 * s], koff[s] + bofs, 0); DSR(kf[2 * s + 1], koff[s] + bofs, 32 * KROW); }
          WAIT8(kf);
          if (NS > 4) asm volatile("" : "+v"(kf[8]), "+v"(kf[9]), "+v"(kf[10 % (2 * NS)]), "+v"(kf[11 % (2 * NS)]));
          p0 = MFMA(kf[0], qf[0], negm); p1 = MFMA(kf[1], qf[0], negm);
#pragma unroll
          for (int s = 1; s < NS; ++s) { p0 = MFMA(kf[2 * s], qf[s], p0); p1 = MFMA(kf[2 * s + 1], qf[s], p1); }
        }
        h16x8 vf[8];
#pragma unroll
        for (int i = 0; i < 8; ++i) DSR(vf[i], voff[i & 3] + bofs, (i >> 2) * 4096);
        if (MODE == 1 && !ctxq && t >= 4) {
          const int dr = krow - rq + 7;
#pragma unroll
          for (int e = 0; e < 16; ++e) {
            const int kc0 = crow(e, hh), kc1 = 32 + kc0;
            const bool in0 = (kc0 >= cs) && (kc0 < cs + 16), in1 = (kc1 >= cs) && (kc1 < cs + 16);
            const int i0 = in0 ? dr * 31 + kc0 - qcol + 15 : 0, i1 = in1 ? dr * 31 + kc1 - qcol + 15 : 0;
            const float b0v = rpbL[i0], b1v = rpbL[i1];
            p0[e] = in0 ? p0[e] + b0v : -1e30f;
            p1[e] = in1 ? p1[e] + b1v : -1e30f;
          }
        }
        float mx = xhalf_max(rowmax32(p0, p1));
        if (t == 0 || __builtin_amdgcn_ballot_w64(mx > 8.f) != 0) {
          const float d = (t == 0) ? mx : fmaxf(mx, 0.f);
          m += d;
#pragma unroll
          for (int e = 0; e < 16; ++e) { p0[e] -= d; p1[e] -= d; negm[e] = -m; }
          if (t != 0) {
            const float alpha = fexp2(-d);
            lsum *= alpha;
#pragma unroll
            for (int dt = 0; dt < NDT; ++dt)
#pragma unroll
              for (int e = 0; e < 16; ++e) o[dt][e] *= alpha;
          }
        }
#pragma unroll
        for (int e = 0; e < 16; ++e) { p0[e] = fexp2(p0[e]); p1[e] = fexp2(p1[e]); }
        {
          const f32x16 ps = p0 + p1;
          lsum += ((ps[0] + ps[1]) + (ps[2] + ps[3])) + ((ps[4] + ps[5]) + (ps[6] + ps[7])) + ((ps[8] + ps[9]) + (ps[10] + ps[11])) + ((ps[12] + ps[13]) + (ps[14] + ps[15]));
        }
        h16x8 pb[4];
        {
          u32x4 w0, w1, w2, w3;
#pragma unroll
          for (int e = 0; e < 4; ++e) { w0[e] = pk_h2(p0[2 * e], p0[2 * e + 1]); w1[e] = pk_h2(p0[8 + 2 * e], p0[9 + 2 * e]);
                                        w2[e] = pk_h2(p1[2 * e], p1[2 * e + 1]); w3[e] = pk_h2(p1[8 + 2 * e], p1[9 + 2 * e]); }
          pb[0] = __builtin_bit_cast(h16x8, w0); pb[1] = __builtin_bit_cast(h16x8, w1); pb[2] = __builtin_bit_cast(h16x8, w2); pb[3] = __builtin_bit_cast(h16x8, w3);
        }
        WAIT8(vf);
        if (NDT == 4) {
#pragma unroll
          for (int i = 0; i < 8; ++i) o[i >> 2] = MFMA(vf[i], pb[i & 3], o[i >> 2]);
          h16x8 vg[8];
#pragma unroll
          for (int i = 0; i < 4; ++i) DSR(vg[i], voff[i & 3] + bofs, 8192);
#pragma unroll
          for (int i = 4; i < 8; ++i) DSR(vg[i], voff[i & 3] + bofs, 12288);
          WAIT8(vg);
#pragma unroll
          for (int i = 0; i < 8; ++i) o[(2 + (i >> 2)) % NDT] = MFMA(vg[i], pb[i & 3], o[(2 + (i >> 2)) % NDT]);
        } else {
#pragma unroll
          for (int i = 0; i < 8; ++i) o[(i >> 2) % NDT] = MFMA(vf[i], pb[i & 3], o[(i >> 2) % NDT]);
        }
      }
      if (t + 1 < ntiles) TWRITE(buf ^ 1)
      __syncthreads();
    }
#undef DSR
#undef WAIT8
#undef KV0
#undef TLOAD
#undef TWRITE
    const float lt = xhalf_sum(lsum);
    const float inv = 1.f / lt;
#pragma unroll
    for (int dt = 0; dt < NDT; ++dt)
#pragma unroll
      for (int e = 0; e < 16; ++e) o[dt][e] *= inv;
    h16* st = (h16*)smem + wid * 32 * OP;
#pragma unroll
    for (int dt = 0; dt < NDT; ++dt)
#pragma unroll
      for (int g4 = 0; g4 < 4; ++g4) {
        h16x4 w;
#pragma unroll
        for (int i = 0; i < 4; ++i) w[i] = (h16)o[dt][4 * g4 + i];
        *(h16x4*)(st + r * OP + dt * 32 + 8 * g4 + 4 * hh) = w;
      }
    __syncthreads();
    constexpr int CPR = DV / 8, RPP = 64 / CPR;
#pragma unroll
    for (int ps = 0; ps < 32 / RPP; ++ps) {
      const int q = ps * RPP + lane / CPR, c = lane % CPR;
      h16* op = O + (size_t)(b * SALL + q0 + wid * 32 + q) * 1024 + h * DV + c * 8;
      if (NJ == 2 && jj == 1) {
        const h16x8 x1 = *(const h16x8*)(st + q * OP + c * 8);
        const h16x8 x0 = *(const h16x8*)op;
        float xv[8]; float ss = 0.f;
#pragma unroll
        for (int i = 0; i < 8; ++i) { xv[i] = (float)x0[i] - lam * (float)x1[i]; ss += xv[i] * xv[i]; }
        ss += xor_swz<1>(ss); ss += xor_swz<2>(ss); ss += xor_swz<4>(ss); ss += xor_swz<8>(ss);
        const float rstd = rsqrtf(ss * (1.f / (float)DV) + EPS) * post;
        h16x8 ov;
#pragma unroll
        for (int i = 0; i < 8; ++i) ov[i] = (h16)(xv[i] * rstd * subg[c * 8 + i]);
        *(h16x8*)op = ov;
      } else {
        const u32x4 v = *(const u32x4*)(st + q * OP + c * 8);
        *(u32x4*)op = v;
      }
    }
  }
}

template <int DQK, int DV, int MODE, int NJ>
__device__ __forceinline__ void attn_phase_t(const P& p, const int wv, int H, int HK, int HV, int KDIV, int VDIV, bool ctx_out, const float* rpb, float lam,
                                             const float* subg, float post, unsigned char* smem) {
  unsigned char* ws = p.ws; LAUNDER_S(ws);
  const int tid0 = tid_now(wv);
  const h16* Qb = (const h16*)(ws + OFF_Q); const h16* Kb = (const h16*)(ws + OFF_K); const h16* Vt = (const h16*)(ws + OFF_VT);
  h16* O = (h16*)(ws + OFF_HN);
  const int heavy = NB * H * 32;
  const int total = heavy + (ctx_out ? NB * H : 0);
  for (int it = blockIdx.x; it < total; it += gridDim.x) {
    int tid = tid_now(wv);
    int bh, qt;
    if (it < heavy) { const int grp = it >> 8, loc = it & 255; bh = grp * 8 + (loc & 7); qt = 1 + (loc >> 3); }
    else { bh = it - heavy; qt = 0; }
    const int b = bh / H, h = bh - b * H;
    attn_item<DQK, DV, MODE, NJ>(Qb, Kb, Vt, O, 16, HK, HV, KDIV, VDIV, b, h, qt, MODE == 1 ? rpb + (size_t)h * 465 : nullptr, lam, subg, post, smem, tid);
  }
}

__device__ __forceinline__ void phase_attention(const P& p, const int wv, int mixer, bool ctx_out, unsigned char* smem) {
  if (mixer == 0) attn_phase_t<64, 64, 0, 1>(p, wv, 16, 4, 4, 4, 4, ctx_out, nullptr, 0.f, nullptr, 1.f, smem);
  else if (mixer == 1) attn_phase_t<96, 64, 0, 1>(p, wv, 16, 16, 16, 1, 1, ctx_out, nullptr, 0.f, nullptr, 1.f, smem);
  else if (mixer == 2) {
    const float* lf = p.in[23];
    float d1 = 0.f, d2 = 0.f;
    for (int i = 0; i < 64; ++i) { d1 += lf[i] * lf[64 + i]; d2 += lf[128 + i] * lf[192 + i]; }
    const float li = 0.8f - 0.6f * expf(-0.3f * 2.f);
    const float lam = expf(d1) - expf(d2) + li;
    attn_phase_t<64, 128, 0, 2>(p, wv, 8, 16, 8, 1, 2, ctx_out, nullptr, lam, p.in[24], 1.f - li, smem);
  } else attn_phase_t<64, 64, 1, 1>(p, wv, 16, 16, 16, 1, 1, ctx_out, p.in[27], 0.f, nullptr, 1.f, smem);
}

__device__ __forceinline__ void fast_grid_barrier(unsigned* ctr, unsigned& epoch) {
  __syncthreads();
  epoch += 1u;
  if (threadIdx.x == 0) {
    __builtin_amdgcn_fence(__ATOMIC_RELEASE, "agent");
    const unsigned ngrp = gridDim.x >> 3;
    if ((gridDim.x & 7u) == 0u) {
      const unsigned old = __hip_atomic_fetch_add(ctr + 16u * (blockIdx.x & 7u), 1u, __ATOMIC_ACQ_REL, __HIP_MEMORY_SCOPE_AGENT);
      if (old == epoch * ngrp - 1u) __hip_atomic_fetch_add(ctr + 192, 1u, __ATOMIC_RELEASE, __HIP_MEMORY_SCOPE_AGENT);
      const unsigned target = epoch * 8u;
      while (__hip_atomic_load(ctr + 192, __ATOMIC_RELAXED, __HIP_MEMORY_SCOPE_AGENT) < target) __builtin_amdgcn_s_sleep(1);
    } else {
      __hip_atomic_fetch_add(ctr + 192, 1u, __ATOMIC_RELAXED, __HIP_MEMORY_SCOPE_AGENT);
      const unsigned target = epoch * gridDim.x;
      while (__hip_atomic_load(ctr + 192, __ATOMIC_RELAXED, __HIP_MEMORY_SCOPE_AGENT) < target) __builtin_amdgcn_s_sleep(1);
    }
    __builtin_amdgcn_fence(__ATOMIC_ACQUIRE, "agent");
  }
  __syncthreads();
}

__device__ __forceinline__ bool phase_exists(int ph) {
  if (ph == 0 || ph == NPH - 1) return true;
  const int l = (ph - 1) / 9, q = (ph - 1) % 9;
  if ((q == 2 || q == 3) && l != 1) return false;
  return true;
}

__global__ void __launch_bounds__(512, 2) fwd_megakernel(P p) {
  __shared__ __attribute__((aligned(16))) unsigned char smem[135168];
  cg::grid_group grid = cg::this_grid();
  const int wv = __builtin_amdgcn_readfirstlane((int)__builtin_amdgcn_workitem_id_x() >> 6);
  bool first = true;
  int nsync = 0; unsigned bar_epoch = 0u;
  unsigned* bar_ctr = (unsigned*)(p.ws + OFF_CTL);
  for (int ph = p.ph_lo; ph < p.ph_hi; ++ph) {
    if (!phase_exists(ph)) continue;
    if (!first) { if (nsync == 0) grid.sync(); else fast_grid_barrier(bar_ctr, bar_epoch); ++nsync; }
    first = false;
    if (ph == 0) { phase_prep(p, wv, smem); continue; }
    if (ph == NPH - 1) { phase_final(p, wv); continue; }
    const int l = (ph - 1) / 9, q = (ph - 1) % 9;
    const bool ctx_out = l < 3;
    const h16* W = (const h16*)(p.ws + OFF_W);
#ifdef PROBE_REPEAT_MASK
    for (int rep = 0; rep < (((PROBE_REPEAT_MASK) >> q) & 1 ? 2 : 1); ++rep) {
    if (rep) grid.sync();
#endif
    switch (q) {
      case 0: if (l > 0) convert_weights(p, wv, l, smem); phase_modnorm(p, wv, l, 0); break;
      case 1: if (l == 1) phase_gemm_mla1(p, wv, smem); else phase_gemm_inproj(p, wv, l, smem); break;
      case 2: phase_mla_rownorm(p, wv); break;
      case 3: phase_gemm_mla2(p, wv, smem); break;
      case 4: phase_attention(p, wv, l, ctx_out, smem); break;
      case 5: {
        const size_t wo = W_MIX + (l == 0 ? 1572864 : (l == 1 ? 1900544 : 3145728));
        phase_gemm_resid(p, wv, l, (const h16*)(p.ws + OFF_HN), 1024, W + wo, 2, ctx_out, smem); break; }
      case 6: phase_modnorm(p, wv, l, 1); break;
      case 7: phase_gemm_ffnup(p, wv, l, ctx_out, smem); break;
      case 8: phase_gemm_resid(p, wv, l, (const h16*)(p.ws + OFF_BIG), FFN, W + W_DN, 5, ctx_out, smem); break;
    }
#ifdef PROBE_REPEAT_MASK
    }
#endif
  }
}

extern "C" void kernel_launch(void* const* d_in, const int* in_sizes, int n_in, void* d_out, int out_size, void* d_ws, size_t ws_size,
                              hipStream_t stream) {
  static int grid_blocks = 0;
  if (!grid_blocks) {
    int dev = 0, cus = 0, per_cu = 0;
    (void)hipGetDevice(&dev);
    (void)hipDeviceGetAttribute(&cus, hipDeviceAttributeMultiprocessorCount, dev);
    (void)hipOccupancyMaxActiveBlocksPerMultiprocessor(&per_cu, fwd_megakernel, 512, 0);
    if (per_cu > 1) per_cu = 1;
    if (per_cu < 1) per_cu = 1;
    grid_blocks = cus * per_cu;
    if (ws_size < WS_END || n_in != 30) fprintf(stderr, "kernel_launch: workspace %zu < %zu or n_in %d != 30\n", ws_size, (size_t)WS_END, n_in);
  }
  P p{};
  for (int i = 0; i < 30; ++i) p.in[i] = (const float*)d_in[i];
  p.out = (float*)d_out; p.ws = (unsigned char*)d_ws; p.ph_lo = 0; p.ph_hi = NPH;
  (void)hipMemsetAsync((unsigned char*)d_ws + OFF_CTL, 0, 1024, stream);
  void* args[] = {&p};
  hipError_t e = hipLaunchCooperativeKernel((void*)fwd_megakernel, dim3(grid_blocks), dim3(512), args, 0, stream);
  if (e != hipSuccess) fprintf(stderr, "cooperative launch failed: %s (grid %d)\n", hipGetErrorString(e), grid_blocks);
}
```

```cpp
#include <hip/hip_runtime.h>
#include <hip/hip_cooperative_groups.h>
#include <cstdio>
#include <cstdint>
#include <cmath>
namespace cg = cooperative_groups;

typedef _Float16 h16;
typedef _Float16 h16x8 __attribute__((ext_vector_type(8)));
typedef _Float16 h16x4 __attribute__((ext_vector_type(4)));
typedef float f32x16 __attribute__((ext_vector_type(16)));
typedef float f32x4 __attribute__((ext_vector_type(4)));
typedef float f32x2 __attribute__((ext_vector_type(2)));
typedef _Float16 h16x2 __attribute__((ext_vector_type(2)));
typedef unsigned u32x4 __attribute__((ext_vector_type(4)));

constexpr int DM = 1024, NB = 4, SEQ = 8192, NCTX = 256, SALL = 8448, NR = NB * SALL, FFN = 2816;
constexpr float EPS = 1e-6f, LOG2E = 1.4426950408889634f;
constexpr int NPH = 38;

constexpr size_t OFF_X = 0;
constexpr size_t OFF_HN = 138412032;
constexpr size_t OFF_W = 207618048;
constexpr size_t OFF_BIG = 233308160;
constexpr size_t OFF_Q = OFF_BIG, OFF_K = OFF_BIG + 103809024, OFF_VT = OFF_BIG + 207618048;
constexpr size_t OFF_MOD = 510132224;
constexpr size_t OFF_T64 = OFF_MOD + 491520;
constexpr size_t OFF_T32 = OFF_T64 + 16384;
constexpr size_t OFF_CTL = OFF_T32 + 8192;
constexpr size_t WS_END = OFF_CTL + 1024;
constexpr size_t W_UP = 0, W_DN = 5767168, W_MIX = 8650752;

struct P { const float* in[30]; float* out; unsigned char* ws; int ph_lo, ph_hi; };

#define GLD16(ptr) (*(const __attribute__((address_space(1))) u32x4*)(ptr))
#define AS1 __attribute__((address_space(1)))
#define AS3 __attribute__((address_space(3)))
#define LAUNDER_V(x) asm volatile("" : "+v"(x))
#define LAUNDER_S(x) asm volatile("" : "+s"(x))
__device__ __forceinline__ int tid_now(int wv) { unsigned z = 0u; asm volatile("" : "+v"(z)); return (wv << 6) + (int)__builtin_amdgcn_mbcnt_hi(~0u, __builtin_amdgcn_mbcnt_lo(~0u, z)); }
#define MFMA(a, b, c) __builtin_amdgcn_mfma_f32_32x32x16_f16((a), (b), (c), 0, 0, 0)
__device__ __forceinline__ int crow(int reg, int hh) { return (reg & 3) + 8 * (reg >> 2) + 4 * hh; }
template <int O> __device__ __forceinline__ float xor_swz(float v) {
  return __builtin_bit_cast(float, __builtin_amdgcn_ds_swizzle(__builtin_bit_cast(int, v), (O << 10) | 0x1f));
}
__device__ __forceinline__ float xhalf_sum(float v) {
  const unsigned u = __builtin_bit_cast(unsigned, v);
  auto rr = __builtin_amdgcn_permlane32_swap(u, u, false, false);
  return __builtin_bit_cast(float, (unsigned)rr[0]) + __builtin_bit_cast(float, (unsigned)rr[1]);
}
__device__ __forceinline__ float xhalf_max(float v) {
  const unsigned u = __builtin_bit_cast(unsigned, v);
  auto rr = __builtin_amdgcn_permlane32_swap(u, u, false, false);
  return fmaxf(__builtin_bit_cast(float, (unsigned)rr[0]), __builtin_bit_cast(float, (unsigned)rr[1]));
}
__device__ __forceinline__ float wave_sum(float v) {
  v += xor_swz<1>(v); v += xor_swz<2>(v); v += xor_swz<4>(v); v += xor_swz<8>(v); v += xor_swz<16>(v);
  return xhalf_sum(v);
}
__device__ __forceinline__ int swap23(int s) { return (s & ~12) | ((s & 4) << 1) | ((s & 8) >> 1); }
__device__ __forceinline__ float fexp2(float x) { return __builtin_amdgcn_exp2f(x); }
__device__ __forceinline__ float max3f(float a, float b, float c) { float r; asm("v_max3_f32 %0, %1, %2, %3" : "=v"(r) : "v"(a), "v"(b), "v"(c)); return r; }
__device__ __forceinline__ float rowmax32(const f32x16& a, const f32x16& b) {
  float x = max3f(a[0], a[1], b[0]), y = max3f(a[2], a[3], b[1]);
  x = max3f(x, b[2], b[3]);
#pragma unroll
  for (int e = 4; e < 16; e += 4) { x = max3f(x, a[e], a[e + 1]); y = max3f(y, a[e + 2], a[e + 3]); x = max3f(x, b[e], b[e + 1]); y = max3f(y, b[e + 2], b[e + 3]); }
  float r; asm("v_max_f32_e32 %0, %1, %2" : "=v"(r) : "v"(x), "v"(y)); return r;
}
__device__ __forceinline__ unsigned pk_h2(float a, float b) { const f32x2 v = {a, b}; return __builtin_bit_cast(unsigned, __builtin_convertvector(v, h16x2)); }

__device__ __forceinline__ void mod_item(const P& p, const int wv, int it, unsigned char* smem, const int tid) {
  unsigned char* ws = p.ws; LAUNDER_S(ws);
  const int l = it / 96, cb = it % 96;
  float* sv = (float*)smem;
  for (int i = tid; i < 5120; i += 512) {
    const int g = i >> 10, k = i & 1023;
    const float c = g < 4 ? p.in[1][g * 1024 + k] : p.in[3][k];
    sv[i] = c / (1.f + __expf(-c));
  }
  __syncthreads();
  const int kq = tid >> 6, lane = tid & 63, n = cb * 64 + lane;
  const float* w = p.in[4] + ((size_t)l * 1024 + kq * 128) * 6144 + n;
  const float* s = sv + kq * 128;
  float a0 = 0.f, a1 = 0.f, a2 = 0.f, a3 = 0.f, a4 = 0.f;
#pragma unroll 8
  for (int k = 0; k < 128; ++k) {
    const float wv = w[(size_t)k * 6144];
    a0 += s[k] * wv; a1 += s[1024 + k] * wv; a2 += s[2048 + k] * wv; a3 += s[3072 + k] * wv; a4 += s[4096 + k] * wv;
  }
  float* red = sv + 5120;
  red[(kq * 5 + 0) * 64 + lane] = a0; red[(kq * 5 + 1) * 64 + lane] = a1; red[(kq * 5 + 2) * 64 + lane] = a2;
  red[(kq * 5 + 3) * 64 + lane] = a3; red[(kq * 5 + 4) * 64 + lane] = a4;
  __syncthreads();
  float* MOD = (float*)(ws + OFF_MOD);
  for (int i = tid; i < 320; i += 512) {
    const int g = i >> 6, ln = i & 63, nn = cb * 64 + ln;
    float v = p.in[5][l * 6144 + nn];
#pragma unroll
    for (int q8 = 0; q8 < 8; ++q8) v += red[(q8 * 5 + g) * 64 + ln];
    MOD[(size_t)(l * 5 + g) * 6144 + nn] = v;
  }
  __syncthreads();
}

__device__ __forceinline__ void transpose_tile(const float* __restrict__ src, int K, int N, int Npad, h16* __restrict__ dst, int mode, int tile,
                                               unsigned char* smem, const int tid) {
  const int ntn = Npad >> 6;
  const int k0 = (tile / ntn) * 64, n0 = (tile % ntn) * 64;
  float* tl = (float*)smem;
#pragma unroll
  for (int ps = 0; ps < 2; ++ps) {
    const int k = ps * 32 + (tid >> 4), nn = n0 + (tid & 15) * 4;
    f32x4 v = {0.f, 0.f, 0.f, 0.f};
    if (nn < N) v = *(const f32x4*)(src + (size_t)(k0 + k) * N + nn);
    float* t = tl + k * 65 + (tid & 15) * 4;
    t[0] = v[0]; t[1] = v[1]; t[2] = v[2]; t[3] = v[3];
  }
  __syncthreads();
  const int n = tid >> 3, kc = (tid & 7) * 8;
  h16x8 o0;
#pragma unroll
  for (int i = 0; i < 8; ++i) o0[i] = (h16)tl[(kc + i) * 65 + n];
  const int ng = n0 + n;
  int drow = ng;
  if (mode == 1) { drow = ng < FFN ? ((ng >> 7) * 256 + (ng & 127)) : ((((ng - FFN) >> 7) * 256) + 128 + ((ng - FFN) & 127)); }
  h16* d = dst + (size_t)drow * K + k0 + kc;
  *(h16x8*)d = o0;
  __syncthreads();
}

__device__ __forceinline__ int layer_items(int l) { return 2112 + (l == 0 ? 640 : (l == 1 ? 720 : 1024)); }

__device__ __forceinline__ void convert_weights(const P& p, const int wv, int l, unsigned char* smem) {
  int tid = tid_now(wv); LAUNDER_V(tid);
  unsigned char* ws = p.ws; LAUNDER_S(ws);
  h16* W = (h16*)(ws + OFF_W);
  const int total = layer_items(l);
  for (int it = blockIdx.x; it < total; it += gridDim.x) {
    int r = it;
#define TRY(src, K, N, Npad, dst, mode) { const int nt_ = ((K) >> 6) * ((Npad) >> 6); if (r >= 0 && r < nt_) transpose_tile((src), (K), (N), (Npad), (dst), (mode), r, smem, tid); r -= nt_; }
    TRY(p.in[8] + (size_t)l * 1024 * 5632, 1024, 5632, 5632, W + W_UP, 1)
    TRY(p.in[11] + (size_t)l * 2816 * 1024, 2816, 1024, 1024, W + W_DN, 0)
    if (l == 0) {
      TRY(p.in[12], 1024, 1536, 1536, W + W_MIX, 0)
      TRY(p.in[15], 1024, 1024, 1024, W + W_MIX + 1572864, 0)
    } else if (l == 1) {
      TRY(p.in[16], 1024, 672, 768, W + W_MIX, 0)
      TRY(p.in[19], 384, 1536, 1536, W + W_MIX + 786432, 0)
      TRY(p.in[20], 256, 2048, 2048, W + W_MIX + 1376256, 0)
      TRY(p.in[21], 1024, 1024, 1024, W + W_MIX + 1900544, 0)
    } else if (l == 2) {
      TRY(p.in[22], 1024, 3072, 3072, W + W_MIX, 0)
      TRY(p.in[25], 1024, 1024, 1024, W + W_MIX + 3145728, 0)
    } else {
      TRY(p.in[26], 1024, 3072, 3072, W + W_MIX, 0)
      TRY(p.in[28], 1024, 1024, 1024, W + W_MIX + 3145728, 0)
    }
#undef TRY
  }
}

__device__ __forceinline__ void phase_prep(const P& p, const int wv, unsigned char* smem) {
  unsigned char* ws = p.ws; LAUNDER_S(ws);
  int tid = tid_now(wv); LAUNDER_V(tid);
  for (int it = blockIdx.x; it < 384; it += gridDim.x) mod_item(p, wv, it, smem, tid);
  convert_weights(p, wv, 0, smem);
  const size_t gtid = (size_t)blockIdx.x * 512 + tid, nth = (size_t)gridDim.x * 512;
  f32x4* X4 = (f32x4*)(ws + OFF_X);
  for (size_t i0 = gtid; i0 < (size_t)NR * 256; i0 += nth * 8) {
    f32x4 tv[8];
#pragma unroll
    for (int u = 0; u < 8; ++u) {
      const size_t i = i0 + (size_t)u * nth;
      if (i < (size_t)NR * 256) {
        const int row = (int)(i >> 8), c4 = (int)(i & 255);
        const int b = row / SALL, s = row - b * SALL;
        const float* src = s < NCTX ? p.in[2] + (size_t)(b * NCTX + s) * 1024 : p.in[0] + (size_t)(b * SEQ + s - NCTX) * 1024;
        tv[u] = ((const AS1 f32x4*)src)[c4];
      }
    }
#pragma unroll
    for (int u = 0; u < 8; ++u) {
      const size_t i = i0 + (size_t)u * nth;
      if (i < (size_t)NR * 256) ((AS1 f32x4*)X4)[i] = tv[u];
    }
  }
  float* T64 = (float*)(ws + OFF_T64);
  float* T32 = (float*)(ws + OFF_T32);
  for (size_t i = gtid; i < 128 * 16; i += nth) {
    const int pos = (int)(i >> 4), f = (int)(i & 15);
    const float inv = powf(10000.f, -(float)(2 * f) / 32.f);
    const float ang = (float)pos * inv;
    T64[i * 2] = cosf(ang); T64[i * 2 + 1] = sinf(ang);
  }
  for (size_t i = gtid; i < 128 * 8; i += nth) {
    const int pos = (int)(i >> 3), f = (int)(i & 7);
    const float inv = powf(10000.f, -(float)(2 * f) / 16.f);
    const float ang = (float)pos * inv;
    T32[i * 2] = cosf(ang); T32[i * 2 + 1] = sinf(ang);
  }
}

__device__ __forceinline__ void phase_modnorm(const P& p, const int wv, int l, int which) {
  unsigned char* ws = p.ws; LAUNDER_S(ws);
  int tid = tid_now(wv); LAUNDER_V(tid);
  const int lane = tid & 63, wid = tid >> 6;
  const float* X = (const float*)(ws + OFF_X);
  h16* HN = (h16*)(ws + OFF_HN);
  const float* MOD = (const float*)(ws + OFF_MOD);
  const float* g = p.in[which ? 7 : 6] + l * 1024;
  for (int row0 = (blockIdx.x * 8 + wid) * 4; row0 < NR; row0 += gridDim.x * 32) {
    const int b = row0 / SALL, s = row0 - b * SALL, grp = s < NCTX ? 4 : b;
    const float* sh = MOD + (size_t)((l * 5 + grp) * 6 + which * 3) * 1024;
    const float* sc = sh + 1024;
    f32x4 v[4][4]; float rstd[4];
#pragma unroll
    for (int u = 0; u < 4; ++u)
#pragma unroll
      for (int j = 0; j < 4; ++j) v[u][j] = *(const f32x4*)(X + (size_t)(row0 + u) * 1024 + j * 256 + lane * 4);
#pragma unroll
    for (int u = 0; u < 4; ++u) {
      float ss = 0.f;
#pragma unroll
      for (int j = 0; j < 4; ++j) ss += v[u][j][0] * v[u][j][0] + v[u][j][1] * v[u][j][1] + v[u][j][2] * v[u][j][2] + v[u][j][3] * v[u][j][3];
      rstd[u] = rsqrtf(wave_sum(ss) * (1.f / 1024.f) + EPS);
    }
#pragma unroll
    for (int j = 0; j < 4; ++j) {
      const int col = j * 256 + lane * 4;
      const f32x4 gg = *(const f32x4*)(g + col), scv = *(const f32x4*)(sc + col), shv = *(const f32x4*)(sh + col);
#pragma unroll
      for (int u = 0; u < 4; ++u) {
        h16x4 o;
#pragma unroll
        for (int i = 0; i < 4; ++i) o[i] = (h16)(v[u][j][i] * rstd[u] * gg[i] * (1.f + scv[i]) + shv[i]);
        { const int rw = row0 + u;
          *(h16x4*)(HN + ((size_t)(rw >> 8) * 16 + (col >> 6)) * 16384 + (rw & 255) * 64 + (col & 63)) = o; }
      }
    }
  }
}

__device__ __forceinline__ void phase_final(const P& p, const int wv) {
  unsigned char* ws = p.ws; LAUNDER_S(ws);
  int tid = tid_now(wv); LAUNDER_V(tid);
  const int lane = tid & 63, wid = tid >> 6;
  const float* X = (const float*)(ws + OFF_X);
  const float* g = p.in[29];
  for (int orow0 = (blockIdx.x * 8 + wid) * 4; orow0 < NB * SEQ; orow0 += gridDim.x * 32) {
    const int b = orow0 / SEQ, t = orow0 - b * SEQ;
    const AS1 float* xr = (const AS1 float*)(X + (size_t)(b * SALL + NCTX + t) * 1024);
    f32x4 v[4][4]; float rstd[4];
#pragma unroll
    for (int u = 0; u < 4; ++u)
#pragma unroll
      for (int j = 0; j < 4; ++j) v[u][j] = *(const AS1 f32x4*)(xr + (size_t)u * 1024 + j * 256 + lane * 4);
#pragma unroll
    for (int u = 0; u < 4; ++u) {
      float ss = 0.f;
#pragma unroll
      for (int j = 0; j < 4; ++j) ss += v[u][j][0] * v[u][j][0] + v[u][j][1] * v[u][j][1] + v[u][j][2] * v[u][j][2] + v[u][j][3] * v[u][j][3];
      rstd[u] = rsqrtf(wave_sum(ss) * (1.f / 1024.f) + EPS);
    }
#pragma unroll
    for (int j = 0; j < 4; ++j) {
      const int col = j * 256 + lane * 4;
      const f32x4 gg = *(const f32x4*)(g + col);
#pragma unroll
      for (int u = 0; u < 4; ++u) {
        f32x4 o;
#pragma unroll
        for (int i = 0; i < 4; ++i) o[i] = v[u][j][i] * rstd[u] * gg[i];
        *(f32x4*)(p.out + (size_t)(orow0 + u) * 1024 + col) = o;
      }
    }
  }
}

constexpr int GSTAGE = 65536;
__device__ __forceinline__ void gemm_mainloop(const h16* __restrict__ A, int lda, const int (&arow)[4], const h16* __restrict__ Bt, int K, int n0,
                                              unsigned char* smem, f32x16 (&acc)[4][2], const int tid, const int kt0 = 0, const int nkt = -1, const bool a_tiled = false) {
  const int lane = tid & 63, wid = tid >> 6, wm = wid >> 2, wn = wid & 3, r = lane & 31, hh = lane >> 5;
  const int lrow = tid >> 3, lc = tid & 7;
  const char* Ab = (const char*)A; const char* Bb = (const char*)(Bt + (size_t)n0 * K);
  unsigned ao[4], bo[4];
#pragma unroll
  for (int j = 0; j < 4; ++j) { const int row = lrow + 64 * j; const unsigned cs = (unsigned)((lc ^ ((row >> 1) & 7)) * 16);
    const unsigned ar = (unsigned)(arow[j] < 0 ? 0 : arow[j]);
    ao[j] = a_tiled ? ((ar >> 8) * (unsigned)(K >> 6) * 32768u + (ar & 255u) * 128u + cs) : (ar * (unsigned)(lda * 2) + cs);
    bo[j] = (unsigned)row * (unsigned)(K * 2) + cs; }
  const size_t akstep = a_tiled ? 32768 : 128;
  const int wbase = __builtin_amdgcn_readfirstlane(wid * 1024);
#define GLDS(k, bf) { const char* Ak_ = Ab + (size_t)(k) * akstep; const char* Bk_ = Bb + (size_t)(k) * 128; unsigned char* sb_ = smem + (bf) * GSTAGE + wbase; \
      _Pragma("unroll") for (int j = 0; j < 4; ++j) __builtin_amdgcn_global_load_lds((const AS1 unsigned*)(Ak_ + ao[j]), (AS3 unsigned*)(sb_ + j * 8192), 16, 0, 0); \
      _Pragma("unroll") for (int j = 0; j < 4; ++j) __builtin_amdgcn_global_load_lds((const AS1 unsigned*)(Bk_ + bo[j]), (AS3 unsigned*)(sb_ + 32768 + j * 8192), 16, 0, 0); }
#pragma unroll
  for (int i = 0; i < 4; ++i)
#pragma unroll
    for (int j = 0; j < 2; ++j)
#pragma unroll
      for (int e = 0; e < 16; ++e) acc[i][j][e] = 0.f;
  const int swr = (r >> 1) & 7;
  const unsigned lds0 = (unsigned)(uintptr_t)smem;
  unsigned fao[4], fbo[4];
#pragma unroll
  for (int s = 0; s < 4; ++s) { const unsigned co = (unsigned)(((2 * s + hh) ^ swr) << 4);
    fao[s] = lds0 + (wm * 128 + r) * 128 + co; fbo[s] = lds0 + 32768 + (wn * 64 + r) * 128 + co; }
#define FRD(dst, addr, imm) asm volatile("ds_read_b128 %0, %1 offset:%2" : "=v"(dst) : "v"(addr), "i"(imm))
#define FISSUE(FA, FB, s, bofs) { FRD(FA[0], fao[s] + (bofs), 0); FRD(FA[1], fao[s] + (bofs), 4096); FRD(FA[2], fao[s] + (bofs), 8192); FRD(FA[3], fao[s] + (bofs), 12288); \
                                  FRD(FB[0], fbo[s] + (bofs), 0); FRD(FB[1], fbo[s] + (bofs), 4096); }
#define FWAIT(FA, FB, n) asm volatile("s_waitcnt lgkmcnt(" #n ")" : "+v"(FA[0]), "+v"(FA[1]), "+v"(FA[2]), "+v"(FA[3]), "+v"(FB[0]), "+v"(FB[1]))
#define FMMA(FA, FB) { _Pragma("unroll") for (int mt = 0; mt < 4; ++mt) _Pragma("unroll") for (int nt = 0; nt < 2; ++nt) acc[mt][nt] = MFMA(FA[mt], FB[nt], acc[mt][nt]); }
  const int nk = nkt < 0 ? (K >> 6) : nkt;
  const int kend = kt0 + nk;
  int kk = kt0 + (nkt < 0 ? (((int)(blockIdx.x >> 3) * nk) >> 5) : 0);
  GLDS(kk, 0)
  __syncthreads();
  for (int kt = 0; kt < nk; ++kt) {
    const unsigned bofs = (unsigned)((kt & 1) * GSTAGE);
    kk = (kk + 1 == kend) ? kt0 : kk + 1;
    if (kt + 1 < nk) GLDS(kk, (kt & 1) ^ 1)
    asm volatile("" ::: "memory");
    h16x8 fa0[4], fb0[2], fa1[4], fb1[2];
    FISSUE(fa0, fb0, 0, bofs)
    FISSUE(fa1, fb1, 1, bofs)
    FWAIT(fa0, fb0, 6); FMMA(fa0, fb0)
    FISSUE(fa0, fb0, 2, bofs)
    FWAIT(fa1, fb1, 6); FMMA(fa1, fb1)
    FISSUE(fa1, fb1, 3, bofs)
    FWAIT(fa0, fb0, 6); FMMA(fa0, fb0)
    FWAIT(fa1, fb1, 0); FMMA(fa1, fb1)
    asm volatile("" ::: "memory");
    __syncthreads();
  }
#undef GLDS
#undef FRD
#undef FISSUE
#undef FWAIT
#undef FMMA
}

__device__ __forceinline__ int tile_u(int step) {
  const int b = blockIdx.x, g8 = gridDim.x >> 3;
  return (step * 8 + (b & 7)) * g8 + (b >> 3);
}
__device__ __forceinline__ void tile_band(int u, int NTn, int& mt, int& nt) {
  const int bandsz = 4 * NTn, band = u / bandsz, w = u - band * bandsz;
  mt = band * 4 + (w & 3); nt = w >> 2;
}
constexpr int SPITCH = 264;
__device__ __forceinline__ void stage_acc(const f32x16 (&acc)[4][2], unsigned char* smem, const int tid) {
  const int lane = tid & 63, wid = tid >> 6, wm = wid >> 2, wn = wid & 3, r = lane & 31, hh = lane >> 5;
  h16* st = (h16*)smem;
#pragma unroll
  for (int mt = 0; mt < 4; ++mt)
#pragma unroll
    for (int nt = 0; nt < 2; ++nt)
#pragma unroll
      for (int e = 0; e < 16; ++e) st[(wm * 128 + mt * 32 + crow(e, hh)) * SPITCH + wn * 64 + nt * 32 + r] = (h16)acc[mt][nt][e];
  __syncthreads();
}

__device__ __forceinline__ void phase_gemm_resid(const P& p, const int wv, int l, const h16* A, int K, const h16* Bt, int gidx, bool ctx_out, unsigned char* smem) {
  unsigned char* ws = p.ws; LAUNDER_S(ws);
  const int tid0 = tid_now(wv);
  float* X = (float*)(ws + OFF_X);
  const float* MOD = (const float*)(ws + OFF_MOD);
  for (int step = 0; step * (int)gridDim.x < 512; ++step) {
    const int t = tile_u(step);
    if (t >= 512) continue;
    int tid = tid_now(wv);
    const int lane = tid & 63, wid = tid >> 6, wm = wid >> 2, wn = wid & 3, r = lane & 31, hh = lane >> 5;
    int lm, nt_g; tile_band(t, 4, lm, nt_g);
    const int mt_g = (lm >> 5) * 33 + 1 + (lm & 31);
    const int bb = mt_g / 33;
    int arow[4];
#pragma unroll
    for (int j = 0; j < 4; ++j) arow[j] = mt_g * 256 + (tid >> 3) + 64 * j;
    f32x16 acc[4][2];
    gemm_mainloop(A, K, arow, Bt, K, nt_g * 256, smem, acc, tid);
    const float* gate = MOD + (size_t)((l * 5 + bb) * 6 + gidx) * 1024;
#pragma unroll
    for (int nt = 0; nt < 2; ++nt) {
      const int n = nt_g * 256 + wn * 64 + nt * 32 + r;
      const float gv = gate[n];
#pragma unroll
      for (int mt = 0; mt < 4; ++mt) {
        AS1 float* base = (AS1 float*)(X + (size_t)(mt_g * 256 + wm * 128 + mt * 32 + 4 * hh) * 1024 + n);
        float xv[16];
#pragma unroll
        for (int e = 0; e < 16; ++e) xv[e] = base[((e & 3) + 8 * (e >> 2)) * 1024];
#pragma unroll
        for (int e = 0; e < 16; ++e) base[((e & 3) + 8 * (e >> 2)) * 1024] = xv[e] + gv * acc[mt][nt][e];
      }
    }
  }
  if (ctx_out) {
    for (int step = 0; step * (int)gridDim.x < 256; ++step) {
      const int c = tile_u(step);
      if (c >= 256) continue;
      int tid = tid_now(wv);
      const int lane = tid & 63, wid = tid >> 6, wm = wid >> 2, wn = wid & 3, r = lane & 31, hh = lane >> 5;
      const int ct = c >> 4, ks = c & 15, nkf = K >> 6;
      const int nt_g = ct & 3, mt_g = (ct >> 2) * 33;
      const int kt0 = (ks * nkf) >> 4, nkt = (((ks + 1) * nkf) >> 4) - kt0;
      int arow[4];
#pragma unroll
      for (int j = 0; j < 4; ++j) arow[j] = mt_g * 256 + (tid >> 3) + 64 * j;
      f32x16 acc[4][2];
      gemm_mainloop(A, K, arow, Bt, K, nt_g * 256, smem, acc, tid, kt0, nkt);
      const float* gate = MOD + (size_t)((l * 5 + 4) * 6 + gidx) * 1024;
#pragma unroll
      for (int nt = 0; nt < 2; ++nt) {
        const int n = nt_g * 256 + wn * 64 + nt * 32 + r;
        const float gv = gate[n];
#pragma unroll
        for (int mt = 0; mt < 4; ++mt)
#pragma unroll
          for (int e = 0; e < 16; ++e) {
            float* px = X + (size_t)(mt_g * 256 + wm * 128 + mt * 32 + crow(e, hh)) * 1024 + n;
            unsafeAtomicAdd(px, gv * acc[mt][nt][e]);
          }
      }
    }
  }
}

__device__ __forceinline__ void seg_read(const unsigned char* smem, int trow, int col0, float (&v)[64]) {
  const h16* st = (const h16*)smem + trow * SPITCH + col0;
#pragma unroll
  for (int c = 0; c < 8; ++c) {
    const h16x8 x = *(const h16x8*)(st + c * 8);
#pragma unroll
    for (int i = 0; i < 8; ++i) v[c * 8 + i] = (float)x[i];
  }
}
__device__ __forceinline__ void seg_rope64(const float* T64, int s, float (&v)[64]) {
  if (s < NCTX) return;
  const int t = s - NCTX, prow = t >> 6, pcol = t & 63;
  const AS1 f32x4* tr = (const AS1 f32x4*)((const f32x2*)T64 + prow * 16);
  const AS1 f32x4* tc = (const AS1 f32x4*)((const f32x2*)T64 + pcol * 16);
  f32x4 ta[8], tb[8];
#pragma unroll
  for (int f = 0; f < 8; ++f) { ta[f] = tr[f]; tb[f] = tc[f]; }
#pragma unroll
  for (int f = 0; f < 16; ++f) {
    const f32x2 a = {ta[f >> 1][(f & 1) * 2], ta[f >> 1][(f & 1) * 2 + 1]}, c = {tb[f >> 1][(f & 1) * 2], tb[f >> 1][(f & 1) * 2 + 1]};
    const float x1 = v[f], x2 = v[16 + f], x3 = v[32 + f], x4 = v[48 + f];
    v[f] = x1 * a[0] - x2 * a[1]; v[16 + f] = x2 * a[0] + x1 * a[1];
    v[32 + f] = x3 * c[0] - x4 * c[1]; v[48 + f] = x4 * c[0] + x3 * c[1];
  }
}
__device__ __forceinline__ void seg_store_row(h16* dst, const float (&v)[64], float scale) {
#pragma unroll
  for (int c = 0; c < 8; ++c) {
    h16x8 o;
#pragma unroll
    for (int i = 0; i < 8; ++i) o[i] = (h16)(v[c * 8 + i] * scale);
    *(h16x8*)(dst + c * 8) = o;
  }
}
__device__ __forceinline__ void seg_store_vt(h16* dst  , const float (&v)[64]) {
#pragma unroll
  for (int d = 0; d < 64; ++d) dst[(size_t)d * SALL] = (h16)v[d];
}

__device__ __forceinline__ void phase_gemm_inproj(const P& p, const int wv, int mixer, unsigned char* smem) {
  unsigned char* ws = p.ws; LAUNDER_S(ws);
  const int tid0 = tid_now(wv);
  const h16* HN = (const h16*)(ws + OFF_HN);
  const h16* Wt = (const h16*)(ws + OFF_W) + W_MIX;
  h16* Qb = (h16*)(ws + OFF_Q); h16* Kb = (h16*)(ws + OFF_K); h16* Vt = (h16*)(ws + OFF_VT);
  const float* T64 = (const float*)(ws + OFF_T64);
  const int NT = mixer == 0 ? 6 : 12;
  const int ntiles = 132 * NT;
  const float qscale = 0.125f * LOG2E;
  for (int step = 0; step * (int)gridDim.x < ntiles; ++step) {
    const int t = tile_u(step);
    if (t >= ntiles) continue;
    int tid = tid_now(wv);
    int mt_g, nt_g;
    if (t < 128 * NT) { int lm; tile_band(t, NT, lm, nt_g); mt_g = (lm >> 5) * 33 + 1 + (lm & 31); }
    else { int cm; tile_band(t - 128 * NT, NT, cm, nt_g); mt_g = cm * 33; }
    int arow[4];
#pragma unroll
    for (int j = 0; j < 4; ++j) arow[j] = mt_g * 256 + (tid >> 3) + 64 * j;
    f32x16 acc[4][2];
    gemm_mainloop(HN, 1024, arow, Wt, 1024, nt_g * 256, smem, acc, tid, 0, -1, true);
    stage_acc(acc, smem, tid);
    const int trow = tid & 255, sh = tid >> 8;
    const int grow = mt_g * 256 + trow;
    const int b = grow / SALL, s = grow - b * SALL;
#pragma unroll 1
    for (int sg = 0; sg < 2; ++sg) {
      const int seg = sh * 2 + sg;
      const int col0 = nt_g * 256 + seg * 64;
      float v[64];
      seg_read(smem, trow, seg * 64, v);
      if (mixer == 0) {
        if (col0 < 1280) {
          const bool isq = col0 < 1024;
          const float* g = isq ? p.in[13] : p.in[14];
          float ss = 0.f;
#pragma unroll
          for (int d = 0; d < 64; ++d) ss += v[d] * v[d];
          const float rstd = rsqrtf(ss * (1.f / 64.f) + EPS);
#pragma unroll
          for (int d = 0; d < 64; ++d) v[d] = v[d] * rstd * g[d];
          seg_rope64(T64, s, v);
          if (isq) seg_store_row(Qb + ((size_t)(b * 16 + (col0 >> 6)) * SALL + s) * 64, v, qscale);
          else seg_store_row(Kb + ((size_t)(b * 4 + ((col0 - 1024) >> 6)) * SALL + s) * 64, v, 1.f);
        } else {
          seg_store_vt(Vt + (size_t)(b * 4 + ((col0 - 1280) >> 6)) * 64 * SALL + swap23(s), v);
        }
      } else if (mixer == 2) {
        if (col0 < 2048) {
          seg_rope64(T64, s, v);
          if (col0 < 1024) seg_store_row(Qb + ((size_t)(b * 16 + (col0 >> 6)) * SALL + s) * 64, v, qscale);
          else seg_store_row(Kb + ((size_t)(b * 16 + ((col0 - 1024) >> 6)) * SALL + s) * 64, v, 1.f);
        } else {
          const int c = col0 - 2048;
          seg_store_vt(Vt + ((size_t)(b * 8 + (c >> 7)) * 128 + (c & 127)) * SALL + swap23(s), v);
        }
      } else {
        if (col0 < 1024) seg_store_row(Qb + ((size_t)(b * 16 + (col0 >> 6)) * SALL + s) * 64, v, qscale);
        else if (col0 < 2048) seg_store_row(Kb + ((size_t)(b * 16 + ((col0 - 1024) >> 6)) * SALL + s) * 64, v, 1.f);
        else seg_store_vt(Vt + (size_t)(b * 16 + ((col0 - 2048) >> 6)) * 64 * SALL + swap23(s), v);
      }
    }
    __syncthreads();
  }
}

__device__ __forceinline__ void phase_gemm_mla1(const P& p, const int wv, unsigned char* smem) {
  unsigned char* ws = p.ws; LAUNDER_S(ws);
  const int tid0 = tid_now(wv);
  const h16* HN = (const h16*)(ws + OFF_HN);
  const h16* Wt = (const h16*)(ws + OFF_W) + W_MIX;
  h16* C1 = (h16*)(ws + OFF_VT);
  const int ntiles = 132 * 3;
  for (int step = 0; step * (int)gridDim.x < ntiles; ++step) {
    const int t = tile_u(step);
    if (t >= ntiles) continue;
    int tid = tid_now(wv);
    const int lane = tid & 63, wid = tid >> 6, wm = wid >> 2, wn = wid & 3, r = lane & 31, hh = lane >> 5;
    int mt_g, nt_g;
    tile_band(t, 3, mt_g, nt_g);
    int arow[4];
#pragma unroll
    for (int j = 0; j < 4; ++j) arow[j] = mt_g * 256 + (tid >> 3) + 64 * j;
    f32x16 acc[4][2];
    gemm_mainloop(HN, 1024, arow, Wt, 1024, nt_g * 256, smem, acc, tid, 0, -1, true);
#pragma unroll
    for (int mt = 0; mt < 4; ++mt)
#pragma unroll
      for (int nt = 0; nt < 2; ++nt)
#pragma unroll
        for (int e = 0; e < 16; ++e)
          C1[(size_t)(mt_g * 256 + wm * 128 + mt * 32 + crow(e, hh)) * 768 + nt_g * 256 + wn * 64 + nt * 32 + r] = (h16)acc[mt][nt][e];
  }
}

__device__ __forceinline__ void phase_mla_rownorm(const P& p, const int wv) {
  unsigned char* ws = p.ws; LAUNDER_S(ws);
  int tid = tid_now(wv); LAUNDER_V(tid);
  const int lane = tid & 63, wid = tid >> 6;
  const h16* C1 = (const h16*)(ws + OFF_VT);
  h16* CQN = (h16*)(ws + OFF_HN);
  h16* CKVN = CQN + (size_t)NR * 384;
  h16* Kb = (h16*)(ws + OFF_K);
  const float* T32 = (const float*)(ws + OFF_T32);
  const float* gq = p.in[17]; const float* gkv = p.in[18];
  for (int row = blockIdx.x * 8 + wid; row < NR; row += gridDim.x * 8) {
    const int b = row / SALL, s = row - b * SALL;
    const h16* c = C1 + (size_t)row * 768;
    u32x4 xq_ = {0u, 0u, 0u, 0u}, xkv_ = {0u, 0u, 0u, 0u};
    if (lane < 48) xq_ = GLD16(c + lane * 8);
    if (lane < 32) xkv_ = GLD16(c + 384 + lane * 8);
    const u32x4 xr_ = GLD16(c + 640 + (lane & 3) * 8);
    {
      float v[8]; float ss = 0.f;
      if (lane < 48) { const h16x8 x = __builtin_bit_cast(h16x8, xq_);
#pragma unroll
        for (int i = 0; i < 8; ++i) { v[i] = (float)x[i]; ss += v[i] * v[i]; } }
      else {
#pragma unroll
        for (int i = 0; i < 8; ++i) v[i] = 0.f; }
      const float rstd = rsqrtf(wave_sum(ss) * (1.f / 384.f) + EPS);
      if (lane < 48) { h16x8 o;
#pragma unroll
        for (int i = 0; i < 8; ++i) o[i] = (h16)(v[i] * rstd * gq[lane * 8 + i]);
        *(h16x8*)(CQN + (size_t)row * 384 + lane * 8) = o; }
    }
    {
      float v[8]; float ss = 0.f;
      if (lane < 32) { const h16x8 x = __builtin_bit_cast(h16x8, xkv_);
#pragma unroll
        for (int i = 0; i < 8; ++i) { v[i] = (float)x[i]; ss += v[i] * v[i]; } }
      else {
#pragma unroll
        for (int i = 0; i < 8; ++i) v[i] = 0.f; }
      const float rstd = rsqrtf(wave_sum(ss) * (1.f / 256.f) + EPS);
      if (lane < 32) { h16x8 o;
#pragma unroll
        for (int i = 0; i < 8; ++i) o[i] = (h16)(v[i] * rstd * gkv[lane * 8 + i]);
        *(h16x8*)(CKVN + (size_t)row * 256 + lane * 8) = o; }
    }
    {
      const int part = lane & 3, head = lane >> 2;
      const h16x8 x = __builtin_bit_cast(h16x8, xr_);
      float v[8], w[8];
#pragma unroll
      for (int i = 0; i < 8; ++i) { v[i] = (float)x[i]; w[i] = xor_swz<1>(v[i]); }
      if (s >= NCTX) {
        const int t = s - NCTX; const int pos = (part < 2) ? (t >> 6) : (t & 63);
        const f32x2* tb = (const f32x2*)T32 + pos * 8;
#pragma unroll
        for (int i = 0; i < 8; ++i) { const f32x2 cs = tb[i];
          v[i] = (part & 1) ? (v[i] * cs[0] + w[i] * cs[1]) : (v[i] * cs[0] - w[i] * cs[1]); }
      }
      h16x8 o;
#pragma unroll
      for (int i = 0; i < 8; ++i) o[i] = (h16)v[i];
      *(h16x8*)(Kb + ((size_t)(b * 16 + head) * SALL + s) * 96 + 64 + part * 8) = o;
    }
  }
}

__device__ __forceinline__ void phase_gemm_mla2(const P& p, const int wv, unsigned char* smem) {
  unsigned char* ws = p.ws; LAUNDER_S(ws);
  const int tid0 = tid_now(wv);
  const h16* CQN = (const h16*)(ws + OFF_HN);
  const h16* CKVN = CQN + (size_t)NR * 384;
  const h16* Wuq = (const h16*)(ws + OFF_W) + W_MIX + 786432;
  const h16* Wukv = (const h16*)(ws + OFF_W) + W_MIX + 1376256;
  h16* Qb = (h16*)(ws + OFF_Q); h16* Kb = (h16*)(ws + OFF_K); h16* Vt = (h16*)(ws + OFF_VT);
  const float* T32 = (const float*)(ws + OFF_T32);
  const float qscale = 0.10206207261596577f * LOG2E;
  const int ntiles = 132 * 14;
  for (int step = 0; step * (int)gridDim.x < ntiles; ++step) {
    const int t = tile_u(step);
    if (t >= ntiles) continue;
    int tid = tid_now(wv);
    int mt_g, nn;
    if (t < 128 * 14) { int lm; tile_band(t, 14, lm, nn); mt_g = (lm >> 5) * 33 + 1 + (lm & 31); }
    else { int cm; tile_band(t - 128 * 14, 14, cm, nn); mt_g = cm * 33; }
    int arow[4];
#pragma unroll
    for (int j = 0; j < 4; ++j) arow[j] = mt_g * 256 + (tid >> 3) + 64 * j;
    f32x16 acc[4][2];
    const int trow = tid & 255, sh = tid >> 8;
    const int grow = mt_g * 256 + trow;
    const int b = grow / SALL, s = grow - b * SALL;
    if (nn < 6) {
      gemm_mainloop(CQN, 384, arow, Wuq, 384, nn * 256, smem, acc, tid);
      stage_acc(acc, smem, tid);
      const h16* st = (const h16*)smem + trow * SPITCH;
#pragma unroll 1
      for (int i2 = 0; i2 < 16; ++i2) {
        const int i = sh * 16 + i2;
        const int c0 = nn * 256 + i * 8, head = c0 / 96, dd = c0 - head * 96;
        h16* dst = Qb + ((size_t)(b * 16 + head) * SALL + s) * 96 + dd;
        if (dd < 64) {
          const h16x8 x = *(const h16x8*)(st + i * 8); h16x8 o;
#pragma unroll
          for (int e = 0; e < 8; ++e) o[e] = (h16)((float)x[e] * qscale);
          *(h16x8*)dst = o;
        } else if (dd == 64) {
          float v[32];
#pragma unroll
          for (int c = 0; c < 4; ++c) { const h16x8 x = *(const h16x8*)(st + (i + c) * 8);
#pragma unroll
            for (int e = 0; e < 8; ++e) v[c * 8 + e] = (float)x[e]; }
          if (s >= NCTX) {
            const int tt = s - NCTX;
            const f32x2* tr = (const f32x2*)T32 + (tt >> 6) * 8;
            const f32x2* tc = (const f32x2*)T32 + (tt & 63) * 8;
#pragma unroll
            for (int f = 0; f < 8; ++f) {
              const f32x2 a = tr[f], c = tc[f];
              const float x1 = v[f], x2 = v[8 + f], x3 = v[16 + f], x4 = v[24 + f];
              v[f] = x1 * a[0] - x2 * a[1]; v[8 + f] = x2 * a[0] + x1 * a[1];
              v[16 + f] = x3 * c[0] - x4 * c[1]; v[24 + f] = x4 * c[0] + x3 * c[1];
            }
          }
#pragma unroll
          for (int c = 0; c < 4; ++c) { h16x8 o;
#pragma unroll
            for (int e = 0; e < 8; ++e) o[e] = (h16)(v[c * 8 + e] * qscale);
            *(h16x8*)(dst + c * 8) = o; }
        }
      }
    } else {
      gemm_mainloop(CKVN, 256, arow, Wukv, 256, (nn - 6) * 256, smem, acc, tid);
      stage_acc(acc, smem, tid);
      {
        const int head = (nn - 6) * 2 + sh;
        const h16* st = (const h16*)smem + trow * SPITCH + sh * 128;
        h16* dst = Kb + ((size_t)(b * 16 + head) * SALL + s) * 96;
#pragma unroll
        for (int c = 0; c < 8; ++c) *(h16x8*)(dst + c * 8) = *(const h16x8*)(st + c * 8);
        h16* vd = Vt + (size_t)(b * 16 + head) * 64 * SALL + swap23(s);
#pragma unroll
        for (int c = 0; c < 8; ++c) { const h16x8 x = *(const h16x8*)(st + 64 + c * 8);
#pragma unroll
          for (int e = 0; e < 8; ++e) vd[(size_t)(c * 8 + e) * SALL] = x[e]; }
      }
    }
    __syncthreads();
  }
}

__device__ __forceinline__ void phase_gemm_ffnup(const P& p, const int wv, int l, bool ctx_out, unsigned char* smem) {
  unsigned char* ws = p.ws; LAUNDER_S(ws);
  const int tid0 = tid_now(wv);
  const h16* HN = (const h16*)(ws + OFF_HN);
  const h16* Wt = (const h16*)(ws + OFF_W) + W_UP;
  h16* ACT = (h16*)(ws + OFF_BIG);
  const float* cw = p.in[9] + (size_t)l * 3 * 5632;
  const float* cb = p.in[10] + (size_t)l * 5632;
  const int ntiles = 136 * 22;
  for (int step = 0; step * (int)gridDim.x < ntiles; ++step) {
    const int t = tile_u(step);
    if (t >= ntiles) continue;
    int tid = tid_now(wv);
    int mt_g, jt;
    if (t < 132 * 22) { int lm; tile_band(t, 22, lm, jt); mt_g = (lm / 33) * 34 + 1 + (lm % 33); }
    else { int cm; tile_band(t - 132 * 22, 22, cm, jt); mt_g = cm * 34; }
    const int b = mt_g / 34, ti0 = mt_g - b * 34;
    const bool isctx = ti0 == 0;
    if (isctx && !ctx_out) continue;
    const int ti = isctx ? 0 : ti0 - 1;
    const int len = isctx ? NCTX : SEQ;
    const int rowbase = b * SALL + (isctx ? 0 : NCTX);
    const int p0 = isctx ? 0 : 254 * ti - 1;
    int arow[4];
#pragma unroll
    for (int j = 0; j < 4; ++j) { const int pp = p0 + (tid >> 3) + 64 * j; arow[j] = (pp >= 0 && pp < len) ? rowbase + pp : -1; }
    f32x16 acc[4][2];
    gemm_mainloop(HN, 1024, arow, Wt, 1024, jt * 256, smem, acc, tid, 0, -1, true);
    stage_acc(acc, smem, tid);
    const int jc = tid & 15, rbase = tid >> 4;
    const int cv = jt * 128 + jc * 8, cg_ = FFN + cv;
    h16x8 w0v, w1v, w2v, bv, w0g, w1g, w2g, bg;
#pragma unroll
    for (int i = 0; i < 8; ++i) {
      w0v[i] = (h16)cw[cv + i]; w1v[i] = (h16)cw[5632 + cv + i]; w2v[i] = (h16)cw[2 * 5632 + cv + i]; bv[i] = (h16)cb[cv + i];
      w0g[i] = (h16)cw[cg_ + i]; w1g[i] = (h16)cw[5632 + cg_ + i]; w2g[i] = (h16)cw[2 * 5632 + cg_ + i]; bg[i] = (h16)cb[cg_ + i];
    }
    const h16* st = (const h16*)smem;
    const int lo = isctx ? 0 : 1, hi = isctx ? 255 : 254;
#pragma unroll 1
    for (int it = 0; it < 8; ++it) {
      const int sr = rbase + 32 * it;
      const int pp = p0 + sr;
      if (sr >= lo && sr <= hi && pp < len) {
        const h16* r1 = st + sr * SPITCH + jc * 8;
        h16x8 va, vc, ga, gc;
#pragma unroll
        for (int i = 0; i < 8; ++i) { va[i] = (h16)0.f; vc[i] = (h16)0.f; ga[i] = (h16)0.f; gc[i] = (h16)0.f; }
        if (sr > 0 && pp > 0) { va = *(const h16x8*)(r1 - SPITCH); ga = *(const h16x8*)(r1 - SPITCH + 128); }
        if (sr < 255 && pp + 1 < len) { vc = *(const h16x8*)(r1 + SPITCH); gc = *(const h16x8*)(r1 + SPITCH + 128); }
        const h16x8 vb = *(const h16x8*)r1, gb = *(const h16x8*)(r1 + 128);
        const h16x8 uv = va * w0v + vb * w1v + vc * w2v + bv;
        const h16x8 ug = ga * w0g + gb * w1g + gc * w2g + bg;
        const h16x8 tt = ug * uv;
        h16x8 sg;
#pragma unroll
        for (int i = 0; i < 8; ++i) sg[i] = (h16)__builtin_amdgcn_rcpf(1.f + __expf(-(float)ug[i]));
        const h16x8 o = tt * sg;
        *(h16x8*)(ACT + (size_t)(rowbase + pp) * FFN + cv) = o;
      }
    }
    __syncthreads();
  }
}

template <int DQK, int DV, int MODE, int NJ>
__device__ __forceinline__ void attn_item(const h16* __restrict__ Qb, const h16* __restrict__ Kb, const h16* __restrict__ Vtb, h16* __restrict__ O,
                                          int HQ, int HK, int HV, int KDIV, int VDIV, int b, int h, int qt, const float* rpb_h, float lam,
                                          const float* subg, float post, unsigned char* smem, const int tid) {
  constexpr int KROW = (DQK == 64) ? 128 : 256;
  constexpr int KT_BYTES = 64 * KROW, VT_BYTES = DV * 128, BUF = KT_BYTES + VT_BYTES;
  constexpr int KCH = 64 * (DQK / 8);
  constexpr int NKC = (KCH + 511) / 512;
  constexpr int NVC = DV * 8 / 512;
  constexpr int NDT = DV / 32, NS = DQK / 16;
  constexpr int OP = DV + 8;
  const int lane = tid & 63, wid = tid >> 6, r = lane & 31, hh = lane >> 5;
  const bool ctxq = qt == 0;
  const int q0 = qt * 256;
  int ntiles = ctxq ? 4 : 132;
  const int rot = ctxq ? 0 : (((qt - 1) & 31) * 33) >> 3;
  int bs = 0, rq = 0, qcol = 0, rsq = 0, cs = 0;
  float* rpbL = (float*)(smem + 49152);
  if (MODE == 1) {
    if (!ctxq) {
      const int r0 = 4 * (qt - 1);
      bs = min(max(r0 - 4, 0), 120);
      const int be = min(max(r0 + 3 - 4, 0), 120) + 8;
      ntiles = 4 + (be - bs);
      rq = r0 + (wid >> 1); qcol = (wid & 1) * 32 + r;
      rsq = min(max(rq - 4, 0), 120); cs = min(max(qcol - 8, 0), 48);
    }
    __syncthreads();
    for (int i = tid; i < 465; i += 512) rpbL[i] = rpb_h[i] * LOG2E;
  }
  const unsigned lds0 = (unsigned)(uintptr_t)smem;
  unsigned koff[NS], voff[4];
#pragma unroll
  for (int s = 0; s < NS; ++s) { const int c = 2 * s + hh;
    koff[s] = lds0 + ((DQK == 64) ? (r * 128 + ((c ^ ((r >> 1) & 7)) << 4)) : (r * 256 + ((c ^ (r & 15)) << 4))); }
#pragma unroll
  for (int s = 0; s < 4; ++s) { const int c = 2 * s + hh; voff[s] = lds0 + KT_BYTES + r * 128 + ((c ^ ((r >> 1) & 7)) << 4); }
#define DSR(dst, addr, imm) asm volatile("ds_read_b128 %0, %1 offset:%2" : "=v"(dst) : "v"(addr), "i"(imm))
#define WAIT8(f) asm volatile("s_waitcnt lgkmcnt(0)" : "+v"(f[0]), "+v"(f[1]), "+v"(f[2]), "+v"(f[3]), "+v"(f[4]), "+v"(f[5]), "+v"(f[6]), "+v"(f[7]))
#pragma unroll 1
  for (int jj = 0; jj < NJ; ++jj) {
    const int hq = (NJ == 2) ? 2 * h + jj : h;
    const h16* Qp = Qb + ((size_t)(b * HQ + hq) * SALL + q0 + wid * 32 + r) * DQK + hh * 8;
    const h16* Kp = Kb + (size_t)(b * HK + hq / KDIV) * SALL * DQK;
    const h16* Vp = Vtb + (size_t)(b * HV + hq / VDIV) * DV * SALL;
    h16x8 qf[NS];
#pragma unroll
    for (int s = 0; s < NS; ++s) qf[s] = __builtin_bit_cast(h16x8, GLD16(Qp + s * 16));
    f32x16 o[NDT];
#pragma unroll
    for (int dt = 0; dt < NDT; ++dt)
#pragma unroll
      for (int e = 0; e < 16; ++e) o[dt][e] = 0.f;
    float m = 0.f, lsum = 0.f;
    f32x16 negm;
#pragma unroll
    for (int e = 0; e < 16; ++e) negm[e] = 0.f;
    u32x4 rk[NKC], rv[NVC];
#define KV0(t) ((MODE == 1) ? ((!ctxq && (t) >= 4) ? (NCTX + (bs + (t) - 4) * 64) : ((t) * 64)) : ((((t) + rot) >= ntiles ? ((t) + rot - ntiles) : ((t) + rot)) * 64))
#define TLOAD(t) { const int kv0_ = KV0(t); \
      _Pragma("unroll") for (int i = 0; i < NKC; ++i) { const int ci = tid + 512 * i; if (ci < KCH) rk[i] = GLD16(Kp + (size_t)kv0_ * DQK + ci * 8); } \
      _Pragma("unroll") for (int i = 0; i < NVC; ++i) { const int ci = tid + 512 * i; rv[i] = GLD16(Vp + (size_t)(ci >> 3) * SALL + kv0_ + (ci & 7) * 8); } }
#define TWRITE(bf) { unsigned char* kb_ = smem + (bf) * BUF; \
      _Pragma("unroll") for (int i = 0; i < NKC; ++i) { const int ci = tid + 512 * i; if (ci < KCH) { \
        if (DQK == 64) { const int row = ci >> 3, c = ci & 7; *(u32x4*)(kb_ + row * 128 + ((c ^ ((row >> 1) & 7)) << 4)) = rk[i]; } \
        else { const int row = ci / 12, c = ci - row * 12; *(u32x4*)(kb_ + row * 256 + ((c ^ (row & 15)) << 4)) = rk[i]; } } } \
      _Pragma("unroll") for (int i = 0; i < NVC; ++i) { const int ci = tid + 512 * i; const int d = ci >> 3, c = ci & 7; \
        *(u32x4*)(kb_ + KT_BYTES + d * 128 + ((c ^ ((d >> 1) & 7)) << 4)) = rv[i]; } }
    TLOAD(0)
    __syncthreads();
    TWRITE(0)
    __syncthreads();
    for (int t = 0; t < ntiles; ++t) {
      const int buf = t & 1;
      if (t + 1 < ntiles) TLOAD(t + 1)
      bool active = true; int krow = 0;
      if (MODE == 1 && !ctxq && t >= 4) { krow = bs + t - 4; active = (krow >= rsq) && (krow < rsq + 8); }
      if (active) {
        const unsigned char* kb = smem + buf * BUF;
        const unsigned char* vb = kb + KT_BYTES;
        f32x16 p0, p1;
        const unsigned bofs = (unsigned)(buf * BUF);
        {
          h16x8 kf[2 * NS];
#pragma unroll
          for (int s = 0; s < NS; ++s) { DSR(kf[2 * s], koff[s] + bofs, 0); DSR(kf[2 * s + 1], koff[s] + bofs, 32 * KROW); }
          WAIT8(kf);
          if (NS > 4) asm volatile("" : "+v"(kf[8]), "+v"(kf[9]), "+v"(kf[10 % (2 * NS)]), "+v"(kf[11 % (2 * NS)]));
          p0 = MFMA(kf[0], qf[0], negm); p1 = MFMA(kf[1], qf[0], negm);
#pragma unroll
          for (int s = 1; s < NS; ++s) { p0 = MFMA(kf[2 * s], qf[s], p0); p1 = MFMA(kf[2 * s + 1], qf[s], p1); }
        }
        h16x8 vf[8];
#pragma unroll
        for (int i = 0; i < 8; ++i) DSR(vf[i], voff[i & 3] + bofs, (i >> 2) * 4096);
        if (MODE == 1 && !ctxq && t >= 4) {
          const int dr = krow - rq + 7;
#pragma unroll
          for (int e = 0; e < 16; ++e) {
            const int kc0 = crow(e, hh), kc1 = 32 + kc0;
            const bool in0 = (kc0 >= cs) && (kc0 < cs + 16), in1 = (kc1 >= cs) && (kc1 < cs + 16);
            const int i0 = in0 ? dr * 31 + kc0 - qcol + 15 : 0, i1 = in1 ? dr * 31 + kc1 - qcol + 15 : 0;
            const float b0v = rpbL[i0], b1v = rpbL[i1];
            p0[e] = in0 ? p0[e] + b0v : -1e30f;
            p1[e] = in1 ? p1[e] + b1v : -1e30f;
          }
        }
        float mx = xhalf_max(rowmax32(p0, p1));
        if (t == 0 || __builtin_amdgcn_ballot_w64(mx > 8.f) != 0) {
          const float d = (t == 0) ? mx : fmaxf(mx, 0.f);
          m += d;
#pragma unroll
          for (int e = 0; e < 16; ++e) { p0[e] -= d; p1[e] -= d; negm[e] = -m; }
          if (t != 0) {
            const float alpha = fexp2(-d);
            lsum *= alpha;
#pragma unroll
            for (int dt = 0; dt < NDT; ++dt)
#pragma unroll
              for (int e = 0; e < 16; ++e) o[dt][e] *= alpha;
          }
        }
#pragma unroll
        for (int e = 0; e < 16; ++e) { p0[e] = fexp2(p0[e]); p1[e] = fexp2(p1[e]); }
        {
          const f32x16 ps = p0 + p1;
          lsum += ((ps[0] + ps[1]) + (ps[2] + ps[3])) + ((ps[4] + ps[5]) + (ps[6] + ps[7])) + ((ps[8] + ps[9]) + (ps[10] + ps[11])) + ((ps[12] + ps[13]) + (ps[14] + ps[15]));
        }
        h16x8 pb[4];
        {
          u32x4 w0, w1, w2, w3;
#pragma unroll
          for (int e = 0; e < 4; ++e) { w0[e] = pk_h2(p0[2 * e], p0[2 * e + 1]); w1[e] = pk_h2(p0[8 + 2 * e], p0[9 + 2 * e]);
                                        w2[e] = pk_h2(p1[2 * e], p1[2 * e + 1]); w3[e] = pk_h2(p1[8 + 2 * e], p1[9 + 2 * e]); }
          pb[0] = __builtin_bit_cast(h16x8, w0); pb[1] = __builtin_bit_cast(h16x8, w1); pb[2] = __builtin_bit_cast(h16x8, w2); pb[3] = __builtin_bit_cast(h16x8, w3);
        }
        WAIT8(vf);
        if (NDT == 4) {
#pragma unroll
          for (int i = 0; i < 8; ++i) o[i >> 2] = MFMA(vf[i], pb[i & 3], o[i >> 2]);
          h16x8 vg[8];
#pragma unroll
          for (int i = 0; i < 4; ++i) DSR(vg[i], voff[i & 3] + bofs, 8192);
#pragma unroll
          for (int i = 4; i < 8; ++i) DSR(vg[i], voff[i & 3] + bofs, 12288);
          WAIT8(vg);
#pragma unroll
          for (int i = 0; i < 8; ++i) o[(2 + (i >> 2)) % NDT] = MFMA(vg[i], pb[i & 3], o[(2 + (i >> 2)) % NDT]);
        } else {
#pragma unroll
          for (int i = 0; i < 8; ++i) o[(i >> 2) % NDT] = MFMA(vf[i], pb[i & 3], o[(i >> 2) % NDT]);
        }
      }
      if (t + 1 < ntiles) TWRITE(buf ^ 1)
      __syncthreads();
    }
#undef DSR
#undef WAIT8
#undef KV0
#undef TLOAD
#undef TWRITE
    const float lt = xhalf_sum(lsum);
    const float inv = 1.f / lt;
#pragma unroll
    for (int dt = 0; dt < NDT; ++dt)
#pragma unroll
      for (int e = 0; e < 16; ++e) o[dt][e] *= inv;
    h16* st = (h16*)smem + wid * 32 * OP;
#pragma unroll
    for (int dt = 0; dt < NDT; ++dt)
#pragma unroll
      for (int g4 = 0; g4 < 4; ++g4) {
        h16x4 w;
#pragma unroll
        for (int i = 0; i < 4; ++i) w[i] = (h16)o[dt][4 * g4 + i];
        *(h16x4*)(st + r * OP + dt * 32 + 8 * g4 + 4 * hh) = w;
      }
    __syncthreads();
    constexpr int CPR = DV / 8, RPP = 64 / CPR;
#pragma unroll
    for (int ps = 0; ps < 32 / RPP; ++ps) {
      const int q = ps * RPP + lane / CPR, c = lane % CPR;
      h16* op = O + (size_t)(b * SALL + q0 + wid * 32 + q) * 1024 + h * DV + c * 8;
      if (NJ == 2 && jj == 1) {
        const h16x8 x1 = *(const h16x8*)(st + q * OP + c * 8);
        const h16x8 x0 = *(const h16x8*)op;
        float xv[8]; float ss = 0.f;
#pragma unroll
        for (int i = 0; i < 8; ++i) { xv[i] = (float)x0[i] - lam * (float)x1[i]; ss += xv[i] * xv[i]; }
        ss += xor_swz<1>(ss); ss += xor_swz<2>(ss); ss += xor_swz<4>(ss); ss += xor_swz<8>(ss);
        const float rstd = rsqrtf(ss * (1.f / (float)DV) + EPS) * post;
        h16x8 ov;
#pragma unroll
        for (int i = 0; i < 8; ++i) ov[i] = (h16)(xv[i] * rstd * subg[c * 8 + i]);
        *(h16x8*)op = ov;
      } else {
        const u32x4 v = *(const u32x4*)(st + q * OP + c * 8);
        *(u32x4*)op = v;
      }
    }
  }
}

template <int DQK, int DV, int MODE, int NJ>
__device__ __forceinline__ void attn_phase_t(const P& p, const int wv, int H, int HK, int HV, int KDIV, int VDIV, bool ctx_out, const float* rpb, float lam,
                                             const float* subg, float post, unsigned char* smem) {
  unsigned char* ws = p.ws; LAUNDER_S(ws);
  const int tid0 = tid_now(wv);
  const h16* Qb = (const h16*)(ws + OFF_Q); const h16* Kb = (const h16*)(ws + OFF_K); const h16* Vt = (const h16*)(ws + OFF_VT);
  h16* O = (h16*)(ws + OFF_HN);
  const int heavy = NB * H * 32;
  const int total = heavy + (ctx_out ? NB * H : 0);
  for (int it = blockIdx.x; it < total; it += gridDim.x) {
    int tid = tid_now(wv);
    int bh, qt;
    if (it < heavy) { const int grp = it >> 8, loc = it & 255; bh = grp * 8 + (loc & 7); qt = 1 + (loc >> 3); }
    else { bh = it - heavy; qt = 0; }
    const int b = bh / H, h = bh - b * H;
    attn_item<DQK, DV, MODE, NJ>(Qb, Kb, Vt, O, 16, HK, HV, KDIV, VDIV, b, h, qt, MODE == 1 ? rpb + (size_t)h * 465 : nullptr, lam, subg, post, smem, tid);
  }
}

__device__ __forceinline__ void phase_attention(const P& p, const int wv, int mixer, bool ctx_out, unsigned char* smem) {
  if (mixer == 0) attn_phase_t<64, 64, 0, 1>(p, wv, 16, 4, 4, 4, 4, ctx_out, nullptr, 0.f, nullptr, 1.f, smem);
  else if (mixer == 1) attn_phase_t<96, 64, 0, 1>(p, wv, 16, 16, 16, 1, 1, ctx_out, nullptr, 0.f, nullptr, 1.f, smem);
  else if (mixer == 2) {
    const float* lf = p.in[23];
    float d1 = 0.f, d2 = 0.f;
    for (int i = 0; i < 64; ++i) { d1 += lf[i] * lf[64 + i]; d2 += lf[128 + i] * lf[192 + i]; }
    const float li = 0.8f - 0.6f * expf(-0.3f * 2.f);
    const float lam = expf(d1) - expf(d2) + li;
    attn_phase_t<64, 128, 0, 2>(p, wv, 8, 16, 8, 1, 2, ctx_out, nullptr, lam, p.in[24], 1.f - li, smem);
  } else attn_phase_t<64, 64, 1, 1>(p, wv, 16, 16, 16, 1, 1, ctx_out, p.in[27], 0.f, nullptr, 1.f, smem);
}

__device__ __forceinline__ void fast_grid_barrier(unsigned* ctr, unsigned& epoch) {
  __syncthreads();
  epoch += 1u;
  if (threadIdx.x == 0) {
    __builtin_amdgcn_fence(__ATOMIC_RELEASE, "agent");
    const unsigned ngrp = gridDim.x >> 3;
    if ((gridDim.x & 7u) == 0u) {
      const unsigned old = __hip_atomic_fetch_add(ctr + 16u * (blockIdx.x & 7u), 1u, __ATOMIC_ACQ_REL, __HIP_MEMORY_SCOPE_AGENT);
      if (old == epoch * ngrp - 1u) __hip_atomic_fetch_add(ctr + 192, 1u, __ATOMIC_RELEASE, __HIP_MEMORY_SCOPE_AGENT);
      const unsigned target = epoch * 8u;
      while (__hip_atomic_load(ctr + 192, __ATOMIC_RELAXED, __HIP_MEMORY_SCOPE_AGENT) < target) __builtin_amdgcn_s_sleep(1);
    } else {
      __hip_atomic_fetch_add(ctr + 192, 1u, __ATOMIC_RELAXED, __HIP_MEMORY_SCOPE_AGENT);
      const unsigned target = epoch * gridDim.x;
      while (__hip_atomic_load(ctr + 192, __ATOMIC_RELAXED, __HIP_MEMORY_SCOPE_AGENT) < target) __builtin_amdgcn_s_sleep(1);
    }
    __builtin_amdgcn_fence(__ATOMIC_ACQUIRE, "agent");
  }
  __syncthreads();
}

__device__ __forceinline__ bool phase_exists(int ph) {
  if (ph == 0 || ph == NPH - 1) return true;
  const int l = (ph - 1) / 9, q = (ph - 1) % 9;
  if ((q == 2 || q == 3) && l != 1) return false;
  return true;
}

__global__ void __launch_bounds__(512, 2) fwd_megakernel(P p) {
  __shared__ __attribute__((aligned(16))) unsigned char smem[135168];
  cg::grid_group grid = cg::this_grid();
  const int wv = __builtin_amdgcn_readfirstlane((int)__builtin_amdgcn_workitem_id_x() >> 6);
  bool first = true;
  int nsync = 0; unsigned bar_epoch = 0u;
  unsigned* bar_ctr = (unsigned*)(p.ws + OFF_CTL);
  for (int ph = p.ph_lo; ph < p.ph_hi; ++ph) {
    if (!phase_exists(ph)) continue;
    if (!first) { if (nsync == 0) grid.sync(); else fast_grid_barrier(bar_ctr, bar_epoch); ++nsync; }
    first = false;
    if (ph == 0) { phase_prep(p, wv, smem); continue; }
    if (ph == NPH - 1) { phase_final(p, wv); continue; }
    const int l = (ph - 1) / 9, q = (ph - 1) % 9;
    const bool ctx_out = l < 3;
    const h16* W = (const h16*)(p.ws + OFF_W);
#ifdef PROBE_REPEAT_MASK
    for (int rep = 0; rep < (((PROBE_REPEAT_MASK) >> q) & 1 ? 2 : 1); ++rep) {
    if (rep) grid.sync();
#endif
    switch (q) {
      case 0: if (l > 0) convert_weights(p, wv, l, smem); phase_modnorm(p, wv, l, 0); break;
      case 1: if (l == 1) phase_gemm_mla1(p, wv, smem); else phase_gemm_inproj(p, wv, l, smem); break;
      case 2: phase_mla_rownorm(p, wv); break;
      case 3: phase_gemm_mla2(p, wv, smem); break;
      case 4: phase_attention(p, wv, l, ctx_out, smem); break;
      case 5: {
        const size_t wo = W_MIX + (l == 0 ? 1572864 : (l == 1 ? 1900544 : 3145728));
        phase_gemm_resid(p, wv, l, (const h16*)(p.ws + OFF_HN), 1024, W + wo, 2, ctx_out, smem); break; }
      case 6: phase_modnorm(p, wv, l, 1); break;
      case 7: phase_gemm_ffnup(p, wv, l, ctx_out, smem); break;
      case 8: phase_gemm_resid(p, wv, l, (const h16*)(p.ws + OFF_BIG), FFN, W + W_DN, 5, ctx_out, smem); break;
    }
#ifdef PROBE_REPEAT_MASK
    }
#endif
  }
}

extern "C" void kernel_launch(void* const* d_in, const int* in_sizes, int n_in, void* d_out, int out_size, void* d_ws, size_t ws_size,
                              hipStream_t stream) {
  static int grid_blocks = 0;
  if (!grid_blocks) {
    int dev = 0, cus = 0, per_cu = 0;
    (void)hipGetDevice(&dev);
    (void)hipDeviceGetAttribute(&cus, hipDeviceAttributeMultiprocessorCount, dev);
    (void)hipOccupancyMaxActiveBlocksPerMultiprocessor(&per_cu, fwd_megakernel, 512, 0);
    if (per_cu > 1) per_cu = 1;
    if (per_cu < 1) per_cu = 1;
    grid_blocks = cus * per_cu;
    if (ws_size < WS_END || n_in != 30) fprintf(stderr, "kernel_launch: workspace %zu < %zu or n_in %d != 30\n", ws_size, (size_t)WS_END, n_in);
  }
  P p{};
  for (int i = 0; i < 30; ++i) p.in[i] = (const float*)d_in[i];
  p.out = (float*)d_out; p.ws = (unsigned char*)d_ws; p.ph_lo = 0; p.ph_hi = NPH;
  (void)hipMemsetAsync((unsigned char*)d_ws + OFF_CTL, 0, 1024, stream);
  void* args[] = {&p};
  hipError_t e = hipLaunchCooperativeKernel((void*)fwd_megakernel, dim3(grid_blocks), dim3(512), args, 0, stream);
  if (e != hipSuccess) fprintf(stderr, "cooperative launch failed: %s (grid %d)\n", hipGetErrorString(e), grid_blocks);
}
```

```cpp
#include <hip/hip_runtime.h>
#include <hip/hip_cooperative_groups.h>
#include <cstdio>
#include <cstdint>
#include <cmath>
namespace cg = cooperative_groups;

typedef _Float16 h16;
typedef _Float16 h16x8 __attribute__((ext_vector_type(8)));
typedef _Float16 h16x4 __attribute__((ext_vector_type(4)));
typedef float f32x16 __attribute__((ext_vector_type(16)));
typedef float f32x4 __attribute__((ext_vector_type(4)));
typedef float f32x2 __attribute__((ext_vector_type(2)));
typedef _Float16 h16x2 __attribute__((ext_vector_type(2)));
typedef unsigned u32x4 __attribute__((ext_vector_type(4)));

constexpr int DM = 1024, NB = 4, SEQ = 8192, NCTX = 256, SALL = 8448, NR = NB * SALL, FFN = 2816;
constexpr float EPS = 1e-6f, LOG2E = 1.4426950408889634f;
constexpr int NPH = 38;

constexpr size_t OFF_X = 0;
constexpr size_t OFF_HN = 138412032;
constexpr size_t OFF_W = 207618048;
constexpr size_t OFF_BIG = 233308160;
constexpr size_t OFF_Q = OFF_BIG, OFF_K = OFF_BIG + 103809024, OFF_VT = OFF_BIG + 207618048;
constexpr size_t OFF_MOD = 510132224;
constexpr size_t OFF_T64 = OFF_MOD + 491520;
constexpr size_t OFF_T32 = OFF_T64 + 16384;
constexpr size_t OFF_CTL = OFF_T32 + 8192;
constexpr size_t WS_END = OFF_CTL + 1024;
constexpr size_t W_UP = 0, W_DN = 5767168, W_MIX = 8650752;

struct P { const float* in[30]; float* out; unsigned char* ws; int ph_lo, ph_hi; };

#define GLD16(ptr) (*(const __attribute__((address_space(1))) u32x4*)(ptr))
#define AS1 __attribute__((address_space(1)))
#define AS3 __attribute__((address_space(3)))
#define LAUNDER_V(x) asm volatile("" : "+v"(x))
#define LAUNDER_S(x) asm volatile("" : "+s"(x))
__device__ __forceinline__ int tid_now(int wv) { unsigned z = 0u; asm volatile("" : "+v"(z)); return (wv << 6) + (int)__builtin_amdgcn_mbcnt_hi(~0u, __builtin_amdgcn_mbcnt_lo(~0u, z)); }
#define MFMA(a, b, c) __builtin_amdgcn_mfma_f32_32x32x16_f16((a), (b), (c), 0, 0, 0)
__device__ __forceinline__ int crow(int reg, int hh) { return (reg & 3) + 8 * (reg >> 2) + 4 * hh; }
template <int O> __device__ __forceinline__ float xor_swz(float v) {
  return __builtin_bit_cast(float, __builtin_amdgcn_ds_swizzle(__builtin_bit_cast(int, v), (O << 10) | 0x1f));
}
__device__ __forceinline__ float xhalf_sum(float v) {
  const unsigned u = __builtin_bit_cast(unsigned, v);
  auto rr = __builtin_amdgcn_permlane32_swap(u, u, false, false);
  return __builtin_bit_cast(float, (unsigned)rr[0]) + __builtin_bit_cast(float, (unsigned)rr[1]);
}
__device__ __forceinline__ float xhalf_max(float v) {
  const unsigned u = __builtin_bit_cast(unsigned, v);
  auto rr = __builtin_amdgcn_permlane32_swap(u, u, false, false);
  return fmaxf(__builtin_bit_cast(float, (unsigned)rr[0]), __builtin_bit_cast(float, (unsigned)rr[1]));
}
__device__ __forceinline__ float wave_sum(float v) {
  v += xor_swz<1>(v); v += xor_swz<2>(v); v += xor_swz<4>(v); v += xor_swz<8>(v); v += xor_swz<16>(v);
  return xhalf_sum(v);
}
__device__ __forceinline__ int swap23(int s) { return (s & ~12) | ((s & 4) << 1) | ((s & 8) >> 1); }
__device__ __forceinline__ float fexp2(float x) { return __builtin_amdgcn_exp2f(x); }
__device__ __forceinline__ float max3f(float a, float b, float c) { float r; asm("v_max3_f32 %0, %1, %2, %3" : "=v"(r) : "v"(a), "v"(b), "v"(c)); return r; }
__device__ __forceinline__ float rowmax32(const f32x16& a, const f32x16& b) {
  float x = max3f(a[0], a[1], b[0]), y = max3f(a[2], a[3], b[1]);
  x = max3f(x, b[2], b[3]);
#pragma unroll
  for (int e = 4; e < 16; e += 4) { x = max3f(x, a[e], a[e + 1]); y = max3f(y, a[e + 2], a[e + 3]); x = max3f(x, b[e], b[e + 1]); y = max3f(y, b[e + 2], b[e + 3]); }
  float r; asm("v_max_f32_e32 %0, %1, %2" : "=v"(r) : "v"(x), "v"(y)); return r;
}
__device__ __forceinline__ unsigned pk_h2(float a, float b) { const f32x2 v = {a, b}; return __builtin_bit_cast(unsigned, __builtin_convertvector(v, h16x2)); }

__device__ __forceinline__ void mod_item(const P& p, const int wv, int it, unsigned char* smem, const int tid) {
  unsigned char* ws = p.ws; LAUNDER_S(ws);
  const int l = it / 96, cb = it % 96;
  float* sv = (float*)smem;
  for (int i = tid; i < 5120; i += 512) {
    const int g = i >> 10, k = i & 1023;
    const float c = g < 4 ? p.in[1][g * 1024 + k] : p.in[3][k];
    sv[i] = c / (1.f + __expf(-c));
  }
  __syncthreads();
  const int kq = tid >> 6, lane = tid & 63, n = cb * 64 + lane;
  const float* w = p.in[4] + ((size_t)l * 1024 + kq * 128) * 6144 + n;
  const float* s = sv + kq * 128;
  float a0 = 0.f, a1 = 0.f, a2 = 0.f, a3 = 0.f, a4 = 0.f;
#pragma unroll 8
  for (int k = 0; k < 128; ++k) {
    const float wv = w[(size_t)k * 6144];
    a0 += s[k] * wv; a1 += s[1024 + k] * wv; a2 += s[2048 + k] * wv; a3 += s[3072 + k] * wv; a4 += s[4096 + k] * wv;
  }
  float* red = sv + 5120;
  red[(kq * 5 + 0) * 64 + lane] = a0; red[(kq * 5 + 1) * 64 + lane] = a1; red[(kq * 5 + 2) * 64 + lane] = a2;
  red[(kq * 5 + 3) * 64 + lane] = a3; red[(kq * 5 + 4) * 64 + lane] = a4;
  __syncthreads();
  float* MOD = (float*)(ws + OFF_MOD);
  for (int i = tid; i < 320; i += 512) {
    const int g = i >> 6, ln = i & 63, nn = cb * 64 + ln;
    float v = p.in[5][l * 6144 + nn];
#pragma unroll
    for (int q8 = 0; q8 < 8; ++q8) v += red[(q8 * 5 + g) * 64 + ln];
    MOD[(size_t)(l * 5 + g) * 6144 + nn] = v;
  }
  __syncthreads();
}

__device__ __forceinline__ void transpose_tile(const float* __restrict__ src, int K, int N, int Npad, h16* __restrict__ dst, int mode, int tile,
                                               unsigned char* smem, const int tid) {
  const int ntn = Npad >> 6;
  const int k0 = (tile / ntn) * 64, n0 = (tile % ntn) * 64;
  float* tl = (float*)smem;
#pragma unroll
  for (int ps = 0; ps < 2; ++ps) {
    const int k = ps * 32 + (tid >> 4), nn = n0 + (tid & 15) * 4;
    f32x4 v = {0.f, 0.f, 0.f, 0.f};
    if (nn < N) v = *(const f32x4*)(src + (size_t)(k0 + k) * N + nn);
    float* t = tl + k * 65 + (tid & 15) * 4;
    t[0] = v[0]; t[1] = v[1]; t[2] = v[2]; t[3] = v[3];
  }
  __syncthreads();
  const int n = tid >> 3, kc = (tid & 7) * 8;
  h16x8 o0;
#pragma unroll
  for (int i = 0; i < 8; ++i) o0[i] = (h16)tl[(kc + i) * 65 + n];
  const int ng = n0 + n;
  int drow = ng;
  if (mode == 1) { drow = ng < FFN ? ((ng >> 7) * 256 + (ng & 127)) : ((((ng - FFN) >> 7) * 256) + 128 + ((ng - FFN) & 127)); }
  h16* d = dst + (size_t)drow * K + k0 + kc;
  *(h16x8*)d = o0;
  __syncthreads();
}

__device__ __forceinline__ int layer_items(int l) { return 2112 + (l == 0 ? 640 : (l == 1 ? 720 : 1024)); }

__device__ __forceinline__ void convert_weights(const P& p, const int wv, int l, unsigned char* smem) {
  int tid = tid_now(wv); LAUNDER_V(tid);
  unsigned char* ws = p.ws; LAUNDER_S(ws);
  h16* W = (h16*)(ws + OFF_W);
  const int total = layer_items(l);
  for (int it = blockIdx.x; it < total; it += gridDim.x) {
    int r = it;
#define TRY(src, K, N, Npad, dst, mode) { const int nt_ = ((K) >> 6) * ((Npad) >> 6); if (r >= 0 && r < nt_) transpose_tile((src), (K), (N), (Npad), (dst), (mode), r, smem, tid); r -= nt_; }
    TRY(p.in[8] + (size_t)l * 1024 * 5632, 1024, 5632, 5632, W + W_UP, 1)
    TRY(p.in[11] + (size_t)l * 2816 * 1024, 2816, 1024, 1024, W + W_DN, 0)
    if (l == 0) {
      TRY(p.in[12], 1024, 1536, 1536, W + W_MIX, 0)
      TRY(p.in[15], 1024, 1024, 1024, W + W_MIX + 1572864, 0)
    } else if (l == 1) {
      TRY(p.in[16], 1024, 672, 768, W + W_MIX, 0)
      TRY(p.in[19], 384, 1536, 1536, W + W_MIX + 786432, 0)
      TRY(p.in[20], 256, 2048, 2048, W + W_MIX + 1376256, 0)
      TRY(p.in[21], 1024, 1024, 1024, W + W_MIX + 1900544, 0)
    } else if (l == 2) {
      TRY(p.in[22], 1024, 3072, 3072, W + W_MIX, 0)
      TRY(p.in[25], 1024, 1024, 1024, W + W_MIX + 3145728, 0)
    } else {
      TRY(p.in[26], 1024, 3072, 3072, W + W_MIX, 0)
      TRY(p.in[28], 1024, 1024, 1024, W + W_MIX + 3145728, 0)
    }
#undef TRY
  }
}

__device__ __forceinline__ void phase_prep(const P& p, const int wv, unsigned char* smem) {
  unsigned char* ws = p.ws; LAUNDER_S(ws);
  int tid = tid_now(wv); LAUNDER_V(tid);
  for (int it = blockIdx.x; it < 384; it += gridDim.x) mod_item(p, wv, it, smem, tid);
  convert_weights(p, wv, 0, smem);
  const size_t gtid = (size_t)blockIdx.x * 512 + tid, nth = (size_t)gridDim.x * 512;
  f32x4* X4 = (f32x4*)(ws + OFF_X);
  for (size_t i0 = gtid; i0 < (size_t)NR * 256; i0 += nth * 8) {
    f32x4 tv[8];
#pragma unroll
    for (int u = 0; u < 8; ++u) {
      const size_t i = i0 + (size_t)u * nth;
      if (i < (size_t)NR * 256) {
        const int row = (int)(i >> 8), c4 = (int)(i & 255);
        const int b = row / SALL, s = row - b * SALL;
        const float* src = s < NCTX ? p.in[2] + (size_t)(b * NCTX + s) * 1024 : p.in[0] + (size_t)(b * SEQ + s - NCTX) * 1024;
        tv[u] = ((const AS1 f32x4*)src)[c4];
      }
    }
#pragma unroll
    for (int u = 0; u < 8; ++u) {
      const size_t i = i0 + (size_t)u * nth;
      if (i < (size_t)NR * 256) ((AS1 f32x4*)X4)[i] = tv[u];
    }
  }
  float* T64 = (float*)(ws + OFF_T64);
  float* T32 = (float*)(ws + OFF_T32);
  for (size_t i = gtid; i < 128 * 16; i += nth) {
    const int pos = (int)(i >> 4), f = (int)(i & 15);
    const float inv = powf(10000.f, -(float)(2 * f) / 32.f);
    const float ang = (float)pos * inv;
    T64[i * 2] = cosf(ang); T64[i * 2 + 1] = sinf(ang);
  }
  for (size_t i = gtid; i < 128 * 8; i += nth) {
    const int pos = (int)(i >> 3), f = (int)(i & 7);
    const float inv = powf(10000.f, -(float)(2 * f) / 16.f);
    const float ang = (float)pos * inv;
    T32[i * 2] = cosf(ang); T32[i * 2 + 1] = sinf(ang);
  }
}

__device__ __forceinline__ void phase_modnorm(const P& p, const int wv, int l, int which) {
  unsigned char* ws = p.ws; LAUNDER_S(ws);
  int tid = tid_now(wv); LAUNDER_V(tid);
  const int lane = tid & 63, wid = tid >> 6;
  const float* X = (const float*)(ws + OFF_X);
  h16* HN = (h16*)(ws + OFF_HN);
  const float* MOD = (const float*)(ws + OFF_MOD);
  const float* g = p.in[which ? 7 : 6] + l * 1024;
  for (int row0 = (blockIdx.x * 8 + wid) * 4; row0 < NR; row0 += gridDim.x * 32) {
    const int b = row0 / SALL, s = row0 - b * SALL, grp = s < NCTX ? 4 : b;
    const float* sh = MOD + (size_t)((l * 5 + grp) * 6 + which * 3) * 1024;
    const float* sc = sh + 1024;
    f32x4 v[4][4]; float rstd[4];
#pragma unroll
    for (int u = 0; u < 4; ++u)
#pragma unroll
      for (int j = 0; j < 4; ++j) v[u][j] = *(const f32x4*)(X + (size_t)(row0 + u) * 1024 + j * 256 + lane * 4);
#pragma unroll
    for (int u = 0; u < 4; ++u) {
      float ss = 0.f;
#pragma unroll
      for (int j = 0; j < 4; ++j) ss += v[u][j][0] * v[u][j][0] + v[u][j][1] * v[u][j][1] + v[u][j][2] * v[u][j][2] + v[u][j][3] * v[u][j][3];
      rstd[u] = rsqrtf(wave_sum(ss) * (1.f / 1024.f) + EPS);
    }
#pragma unroll
    for (int j = 0; j < 4; ++j) {
      const int col = j * 256 + lane * 4;
      const f32x4 gg = *(const f32x4*)(g + col), scv = *(const f32x4*)(sc + col), shv = *(const f32x4*)(sh + col);
#pragma unroll
      for (int u = 0; u < 4; ++u) {
        h16x4 o;
#pragma unroll
        for (int i = 0; i < 4; ++i) o[i] = (h16)(v[u][j][i] * rstd[u] * gg[i] * (1.f + scv[i]) + shv[i]);
        { const int rw = row0 + u;
          *(h16x4*)(HN + ((size_t)(rw >> 8) * 16 + (col >> 6)) * 16384 + (rw & 255) * 64 + (col & 63)) = o; }
      }
    }
  }
}

__device__ __forceinline__ void phase_final(const P& p, const int wv) {
  unsigned char* ws = p.ws; LAUNDER_S(ws);
  int tid = tid_now(wv); LAUNDER_V(tid);
  const int lane = tid & 63, wid = tid >> 6;
  const float* X = (const float*)(ws + OFF_X);
  const float* g = p.in[29];
  for (int orow0 = (blockIdx.x * 8 + wid) * 4; orow0 < NB * SEQ; orow0 += gridDim.x * 32) {
    const int b = orow0 / SEQ, t = orow0 - b * SEQ;
    const AS1 float* xr = (const AS1 float*)(X + (size_t)(b * SALL + NCTX + t) * 1024);
    f32x4 v[4][4]; float rstd[4];
#pragma unroll
    for (int u = 0; u < 4; ++u)
#pragma unroll
      for (int j = 0; j < 4; ++j) v[u][j] = *(const AS1 f32x4*)(xr + (size_t)u * 1024 + j * 256 + lane * 4);
#pragma unroll
    for (int u = 0; u < 4; ++u) {
      float ss = 0.f;
#pragma unroll
      for (int j = 0; j < 4; ++j) ss += v[u][j][0] * v[u][j][0] + v[u][j][1] * v[u][j][1] + v[u][j][2] * v[u][j][2] + v[u][j][3] * v[u][j][3];
      rstd[u] = rsqrtf(wave_sum(ss) * (1.f / 1024.f) + EPS);
    }
#pragma unroll
    for (int j = 0; j < 4; ++j) {
      const int col = j * 256 + lane * 4;
      const f32x4 gg = *(const f32x4*)(g + col);
#pragma unroll
      for (int u = 0; u < 4; ++u) {
        f32x4 o;
#pragma unroll
        for (int i = 0; i < 4; ++i) o[i] = v[u][j][i] * rstd[u] * gg[i];
        *(f32x4*)(p.out + (size_t)(orow0 + u) * 1024 + col) = o;
      }
    }
  }
}

constexpr int GSTAGE = 65536;
__device__ __forceinline__ void gemm_mainloop(const h16* __restrict__ A, int lda, const int (&arow)[4], const h16* __restrict__ Bt, int K, int n0,
                                              unsigned char* smem, f32x16 (&acc)[4][2], const int tid, const int kt0 = 0, const int nkt = -1, const bool a_tiled = false) {
  const int lane = tid & 63, wid = tid >> 6, wm = wid >> 2, wn = wid & 3, r = lane & 31, hh = lane >> 5;
  const int lrow = tid >> 3, lc = tid & 7;
  const char* Ab = (const char*)A; const char* Bb = (const char*)(Bt + (size_t)n0 * K);
  unsigned ao[4], bo[4];
#pragma unroll
  for (int j = 0; j < 4; ++j) { const int row = lrow + 64 * j; const unsigned cs = (unsigned)((lc ^ ((row >> 1) & 7)) * 16);
    const unsigned ar = (unsigned)(arow[j] < 0 ? 0 : arow[j]);
    ao[j] = a_tiled ? ((ar >> 8) * (unsigned)(K >> 6) * 32768u + (ar & 255u) * 128u + cs) : (ar * (unsigned)(lda * 2) + cs);
    bo[j] = (unsigned)row * (unsigned)(K * 2) + cs; }
  const size_t akstep = a_tiled ? 32768 : 128;
  const int wbase = __builtin_amdgcn_readfirstlane(wid * 1024);
#define GLDS(k, bf) { const char* Ak_ = Ab + (size_t)(k) * akstep; const char* Bk_ = Bb + (size_t)(k) * 128; unsigned char* sb_ = smem + (bf) * GSTAGE + wbase; \
      _Pragma("unroll") for (int j = 0; j < 4; ++j) __builtin_amdgcn_global_load_lds((const AS1 unsigned*)(Ak_ + ao[j]), (AS3 unsigned*)(sb_ + j * 8192), 16, 0, 0); \
      _Pragma("unroll") for (int j = 0; j < 4; ++j) __builtin_amdgcn_global_load_lds((const AS1 unsigned*)(Bk_ + bo[j]), (AS3 unsigned*)(sb_ + 32768 + j * 8192), 16, 0, 0); }
#pragma unroll
  for (int i = 0; i < 4; ++i)
#pragma unroll
    for (int j = 0; j < 2; ++j)
#pragma unroll
      for (int e = 0; e < 16; ++e) acc[i][j][e] = 0.f;
  const int swr = (r >> 1) & 7;
  const unsigned lds0 = (unsigned)(uintptr_t)smem;
  unsigned fao[4], fbo[4];
#pragma unroll
  for (int s = 0; s < 4; ++s) { const unsigned co = (unsigned)(((2 * s + hh) ^ swr) << 4);
    fao[s] = lds0 + (wm * 128 + r) * 128 + co; fbo[s] = lds0 + 32768 + (wn * 64 + r) * 128 + co; }
#define FRD(dst, addr, imm) asm volatile("ds_read_b128 %0, %1 offset:%2" : "=v"(dst) : "v"(addr), "i"(imm))
#define FISSUE(FA, FB, s, bofs) { FRD(FA[0], fao[s] + (bofs), 0); FRD(FA[1], fao[s] + (bofs), 4096); FRD(FA[2], fao[s] + (bofs), 8192); FRD(FA[3], fao[s] + (bofs), 12288); \
                                  FRD(FB[0], fbo[s] + (bofs), 0); FRD(FB[1], fbo[s] + (bofs), 4096); }
#define FWAIT(FA, FB, n) asm volatile("s_waitcnt lgkmcnt(" #n ")" : "+v"(FA[0]), "+v"(FA[1]), "+v"(FA[2]), "+v"(FA[3]), "+v"(FB[0]), "+v"(FB[1]))
#define FMMA(FA, FB) { _Pragma("unroll") for (int mt = 0; mt < 4; ++mt) _Pragma("unroll") for (int nt = 0; nt < 2; ++nt) acc[mt][nt] = MFMA(FA[mt], FB[nt], acc[mt][nt]); }
  const int nk = nkt < 0 ? (K >> 6) : nkt;
  const int kend = kt0 + nk;
  int kk = kt0;
  GLDS(kk, 0)
  __syncthreads();
  for (int kt = 0; kt < nk; ++kt) {
    const unsigned bofs = (unsigned)((kt & 1) * GSTAGE);
    kk = (kk + 1 == kend) ? kt0 : kk + 1;
    if (kt + 1 < nk) GLDS(kk, (kt & 1) ^ 1)
    asm volatile("" ::: "memory");
    h16x8 fa0[4], fb0[2], fa1[4], fb1[2];
    FISSUE(fa0, fb0, 0, bofs)
    FISSUE(fa1, fb1, 1, bofs)
    FWAIT(fa0, fb0, 6); FMMA(fa0, fb0)
    FISSUE(fa0, fb0, 2, bofs)
    FWAIT(fa1, fb1, 6); FMMA(fa1, fb1)
    FISSUE(fa1, fb1, 3, bofs)
    FWAIT(fa0, fb0, 6); FMMA(fa0, fb0)
    FWAIT(fa1, fb1, 0); FMMA(fa1, fb1)
    asm volatile("" ::: "memory");
    __syncthreads();
  }
#undef GLDS
#undef FRD
#undef FISSUE
#undef FWAIT
#undef FMMA
}

__device__ __forceinline__ int tile_u(int step) {
  const int b = blockIdx.x, g8 = gridDim.x >> 3;
  return (step * 8 + (b & 7)) * g8 + (b >> 3);
}
__device__ __forceinline__ void tile_band(int u, int NTn, int& mt, int& nt) {
  const int bandsz = 4 * NTn, band = u / bandsz, w = u - band * bandsz;
  mt = band * 4 + (w & 3); nt = w >> 2;
}
constexpr int SPITCH = 264;
__device__ __forceinline__ void stage_acc(const f32x16 (&acc)[4][2], unsigned char* smem, const int tid) {
  const int lane = tid & 63, wid = tid >> 6, wm = wid >> 2, wn = wid & 3, r = lane & 31, hh = lane >> 5;
  h16* st = (h16*)smem;
#pragma unroll
  for (int mt = 0; mt < 4; ++mt)
#pragma unroll
    for (int nt = 0; nt < 2; ++nt)
#pragma unroll
      for (int e = 0; e < 16; ++e) st[(wm * 128 + mt * 32 + crow(e, hh)) * SPITCH + wn * 64 + nt * 32 + r] = (h16)acc[mt][nt][e];
  __syncthreads();
}

__device__ __forceinline__ void phase_gemm_resid(const P& p, const int wv, int l, const h16* A, int K, const h16* Bt, int gidx, bool ctx_out, unsigned char* smem) {
  unsigned char* ws = p.ws; LAUNDER_S(ws);
  const int tid0 = tid_now(wv);
  float* X = (float*)(ws + OFF_X);
  const float* MOD = (const float*)(ws + OFF_MOD);
  for (int step = 0; step * (int)gridDim.x < 512; ++step) {
    const int t = tile_u(step);
    if (t >= 512) continue;
    int tid = tid_now(wv);
    const int lane = tid & 63, wid = tid >> 6, wm = wid >> 2, wn = wid & 3, r = lane & 31, hh = lane >> 5;
    int lm, nt_g; tile_band(t, 4, lm, nt_g);
    const int mt_g = (lm >> 5) * 33 + 1 + (lm & 31);
    const int bb = mt_g / 33;
    int arow[4];
#pragma unroll
    for (int j = 0; j < 4; ++j) arow[j] = mt_g * 256 + (tid >> 3) + 64 * j;
    f32x16 acc[4][2];
    gemm_mainloop(A, K, arow, Bt, K, nt_g * 256, smem, acc, tid);
    const float* gate = MOD + (size_t)((l * 5 + bb) * 6 + gidx) * 1024;
#pragma unroll
    for (int nt = 0; nt < 2; ++nt) {
      const int n = nt_g * 256 + wn * 64 + nt * 32 + r;
      const float gv = gate[n];
#pragma unroll
      for (int mt = 0; mt < 4; ++mt) {
        AS1 float* base = (AS1 float*)(X + (size_t)(mt_g * 256 + wm * 128 + mt * 32 + 4 * hh) * 1024 + n);
        float xv[16];
#pragma unroll
        for (int e = 0; e < 16; ++e) xv[e] = base[((e & 3) + 8 * (e >> 2)) * 1024];
#pragma unroll
        for (int e = 0; e < 16; ++e) base[((e & 3) + 8 * (e >> 2)) * 1024] = xv[e] + gv * acc[mt][nt][e];
      }
    }
  }
  if (ctx_out) {
    for (int step = 0; step * (int)gridDim.x < 256; ++step) {
      const int c = tile_u(step);
      if (c >= 256) continue;
      int tid = tid_now(wv);
      const int lane = tid & 63, wid = tid >> 6, wm = wid >> 2, wn = wid & 3, r = lane & 31, hh = lane >> 5;
      const int ct = c >> 4, ks = c & 15, nkf = K >> 6;
      const int nt_g = ct & 3, mt_g = (ct >> 2) * 33;
      const int kt0 = (ks * nkf) >> 4, nkt = (((ks + 1) * nkf) >> 4) - kt0;
      int arow[4];
#pragma unroll
      for (int j = 0; j < 4; ++j) arow[j] = mt_g * 256 + (tid >> 3) + 64 * j;
      f32x16 acc[4][2];
      gemm_mainloop(A, K, arow, Bt, K, nt_g * 256, smem, acc, tid, kt0, nkt);
      const float* gate = MOD + (size_t)((l * 5 + 4) * 6 + gidx) * 1024;
#pragma unroll
      for (int nt = 0; nt < 2; ++nt) {
        const int n = nt_g * 256 + wn * 64 + nt * 32 + r;
        const float gv = gate[n];
#pragma unroll
        for (int mt = 0; mt < 4; ++mt)
#pragma unroll
          for (int e = 0; e < 16; ++e) {
            float* px = X + (size_t)(mt_g * 256 + wm * 128 + mt * 32 + crow(e, hh)) * 1024 + n;
            unsafeAtomicAdd(px, gv * acc[mt][nt][e]);
          }
      }
    }
  }
}

__device__ __forceinline__ void seg_read(const unsigned char* smem, int trow, int col0, float (&v)[64]) {
  const h16* st = (const h16*)smem + trow * SPITCH + col0;
#pragma unroll
  for (int c = 0; c < 8; ++c) {
    const h16x8 x = *(const h16x8*)(st + c * 8);
#pragma unroll
    for (int i = 0; i < 8; ++i) v[c * 8 + i] = (float)x[i];
  }
}
__device__ __forceinline__ void seg_rope64(const float* T64, int s, float (&v)[64]) {
  if (s < NCTX) return;
  const int t = s - NCTX, prow = t >> 6, pcol = t & 63;
  const AS1 f32x4* tr = (const AS1 f32x4*)((const f32x2*)T64 + prow * 16);
  const AS1 f32x4* tc = (const AS1 f32x4*)((const f32x2*)T64 + pcol * 16);
  f32x4 ta[8], tb[8];
#pragma unroll
  for (int f = 0; f < 8; ++f) { ta[f] = tr[f]; tb[f] = tc[f]; }
#pragma unroll
  for (int f = 0; f < 16; ++f) {
    const f32x2 a = {ta[f >> 1][(f & 1) * 2], ta[f >> 1][(f & 1) * 2 + 1]}, c = {tb[f >> 1][(f & 1) * 2], tb[f >> 1][(f & 1) * 2 + 1]};
    const float x1 = v[f], x2 = v[16 + f], x3 = v[32 + f], x4 = v[48 + f];
    v[f] = x1 * a[0] - x2 * a[1]; v[16 + f] = x2 * a[0] + x1 * a[1];
    v[32 + f] = x3 * c[0] - x4 * c[1]; v[48 + f] = x4 * c[0] + x3 * c[1];
  }
}
__device__ __forceinline__ void seg_store_row(h16* dst, const float (&v)[64], float scale) {
#pragma unroll
  for (int c = 0; c < 8; ++c) {
    h16x8 o;
#pragma unroll
    for (int i = 0; i < 8; ++i) o[i] = (h16)(v[c * 8 + i] * scale);
    *(h16x8*)(dst + c * 8) = o;
  }
}
__device__ __forceinline__ void seg_store_vt(h16* dst  , const float (&v)[64]) {
#pragma unroll
  for (int d = 0; d < 64; ++d) dst[(size_t)d * SALL] = (h16)v[d];
}

__device__ __forceinline__ void phase_gemm_inproj(const P& p, const int wv, int mixer, unsigned char* smem) {
  unsigned char* ws = p.ws; LAUNDER_S(ws);
  const int tid0 = tid_now(wv);
  const h16* HN = (const h16*)(ws + OFF_HN);
  const h16* Wt = (const h16*)(ws + OFF_W) + W_MIX;
  h16* Qb = (h16*)(ws + OFF_Q); h16* Kb = (h16*)(ws + OFF_K); h16* Vt = (h16*)(ws + OFF_VT);
  const float* T64 = (const float*)(ws + OFF_T64);
  const int NT = mixer == 0 ? 6 : 12;
  const int ntiles = 132 * NT;
  const float qscale = 0.125f * LOG2E;
  for (int step = 0; step * (int)gridDim.x < ntiles; ++step) {
    const int t = tile_u(step);
    if (t >= ntiles) continue;
    int tid = tid_now(wv);
    int mt_g, nt_g;
    if (t < 128 * NT) { int lm; tile_band(t, NT, lm, nt_g); mt_g = (lm >> 5) * 33 + 1 + (lm & 31); }
    else { int cm; tile_band(t - 128 * NT, NT, cm, nt_g); mt_g = cm * 33; }
    int arow[4];
#pragma unroll
    for (int j = 0; j < 4; ++j) arow[j] = mt_g * 256 + (tid >> 3) + 64 * j;
    f32x16 acc[4][2];
    gemm_mainloop(HN, 1024, arow, Wt, 1024, nt_g * 256, smem, acc, tid, 0, -1, true);
    stage_acc(acc, smem, tid);
    const int trow = tid & 255, sh = tid >> 8;
    const int grow = mt_g * 256 + trow;
    const int b = grow / SALL, s = grow - b * SALL;
#pragma unroll 1
    for (int sg = 0; sg < 2; ++sg) {
      const int seg = sh * 2 + sg;
      const int col0 = nt_g * 256 + seg * 64;
      float v[64];
      seg_read(smem, trow, seg * 64, v);
      if (mixer == 0) {
        if (col0 < 1280) {
          const bool isq = col0 < 1024;
          const float* g = isq ? p.in[13] : p.in[14];
          float ss = 0.f;
#pragma unroll
          for (int d = 0; d < 64; ++d) ss += v[d] * v[d];
          const float rstd = rsqrtf(ss * (1.f / 64.f) + EPS);
#pragma unroll
          for (int d = 0; d < 64; ++d) v[d] = v[d] * rstd * g[d];
          seg_rope64(T64, s, v);
          if (isq) seg_store_row(Qb + ((size_t)(b * 16 + (col0 >> 6)) * SALL + s) * 64, v, qscale);
          else seg_store_row(Kb + ((size_t)(b * 4 + ((col0 - 1024) >> 6)) * SALL + s) * 64, v, 1.f);
        } else {
          seg_store_vt(Vt + (size_t)(b * 4 + ((col0 - 1280) >> 6)) * 64 * SALL + swap23(s), v);
        }
      } else if (mixer == 2) {
        if (col0 < 2048) {
          seg_rope64(T64, s, v);
          if (col0 < 1024) seg_store_row(Qb + ((size_t)(b * 16 + (col0 >> 6)) * SALL + s) * 64, v, qscale);
          else seg_store_row(Kb + ((size_t)(b * 16 + ((col0 - 1024) >> 6)) * SALL + s) * 64, v, 1.f);
        } else {
          const int c = col0 - 2048;
          seg_store_vt(Vt + ((size_t)(b * 8 + (c >> 7)) * 128 + (c & 127)) * SALL + swap23(s), v);
        }
      } else {
        if (col0 < 1024) seg_store_row(Qb + ((size_t)(b * 16 + (col0 >> 6)) * SALL + s) * 64, v, qscale);
        else if (col0 < 2048) seg_store_row(Kb + ((size_t)(b * 16 + ((col0 - 1024) >> 6)) * SALL + s) * 64, v, 1.f);
        else seg_store_vt(Vt + (size_t)(b * 16 + ((col0 - 2048) >> 6)) * 64 * SALL + swap23(s), v);
      }
    }
    __syncthreads();
  }
}

__device__ __forceinline__ void phase_gemm_mla1(const P& p, const int wv, unsigned char* smem) {
  unsigned char* ws = p.ws; LAUNDER_S(ws);
  const int tid0 = tid_now(wv);
  const h16* HN = (const h16*)(ws + OFF_HN);
  const h16* Wt = (const h16*)(ws + OFF_W) + W_MIX;
  h16* C1 = (h16*)(ws + OFF_VT);
  const int ntiles = 132 * 3;
  for (int step = 0; step * (int)gridDim.x < ntiles; ++step) {
    const int t = tile_u(step);
    if (t >= ntiles) continue;
    int tid = tid_now(wv);
    const int lane = tid & 63, wid = tid >> 6, wm = wid >> 2, wn = wid & 3, r = lane & 31, hh = lane >> 5;
    int mt_g, nt_g;
    tile_band(t, 3, mt_g, nt_g);
    int arow[4];
#pragma unroll
    for (int j = 0; j < 4; ++j) arow[j] = mt_g * 256 + (tid >> 3) + 64 * j;
    f32x16 acc[4][2];
    gemm_mainloop(HN, 1024, arow, Wt, 1024, nt_g * 256, smem, acc, tid, 0, -1, true);
#pragma unroll
    for (int mt = 0; mt < 4; ++mt)
#pragma unroll
      for (int nt = 0; nt < 2; ++nt)
#pragma unroll
        for (int e = 0; e < 16; ++e)
          C1[(size_t)(mt_g * 256 + wm * 128 + mt * 32 + crow(e, hh)) * 768 + nt_g * 256 + wn * 64 + nt * 32 + r] = (h16)acc[mt][nt][e];
  }
}

__device__ __forceinline__ void phase_mla_rownorm(const P& p, const int wv) {
  unsigned char* ws = p.ws; LAUNDER_S(ws);
  int tid = tid_now(wv); LAUNDER_V(tid);
  const int lane = tid & 63, wid = tid >> 6;
  const h16* C1 = (const h16*)(ws + OFF_VT);
  h16* CQN = (h16*)(ws + OFF_HN);
  h16* CKVN = CQN + (size_t)NR * 384;
  h16* Kb = (h16*)(ws + OFF_K);
  const float* T32 = (const float*)(ws + OFF_T32);
  const float* gq = p.in[17]; const float* gkv = p.in[18];
  for (int row = blockIdx.x * 8 + wid; row < NR; row += gridDim.x * 8) {
    const int b = row / SALL, s = row - b * SALL;
    const h16* c = C1 + (size_t)row * 768;
    u32x4 xq_ = {0u, 0u, 0u, 0u}, xkv_ = {0u, 0u, 0u, 0u};
    if (lane < 48) xq_ = GLD16(c + lane * 8);
    if (lane < 32) xkv_ = GLD16(c + 384 + lane * 8);
    const u32x4 xr_ = GLD16(c + 640 + (lane & 3) * 8);
    {
      float v[8]; float ss = 0.f;
      if (lane < 48) { const h16x8 x = __builtin_bit_cast(h16x8, xq_);
#pragma unroll
        for (int i = 0; i < 8; ++i) { v[i] = (float)x[i]; ss += v[i] * v[i]; } }
      else {
#pragma unroll
        for (int i = 0; i < 8; ++i) v[i] = 0.f; }
      const float rstd = rsqrtf(wave_sum(ss) * (1.f / 384.f) + EPS);
      if (lane < 48) { h16x8 o;
#pragma unroll
        for (int i = 0; i < 8; ++i) o[i] = (h16)(v[i] * rstd * gq[lane * 8 + i]);
        *(h16x8*)(CQN + (size_t)row * 384 + lane * 8) = o; }
    }
    {
      float v[8]; float ss = 0.f;
      if (lane < 32) { const h16x8 x = __builtin_bit_cast(h16x8, xkv_);
#pragma unroll
        for (int i = 0; i < 8; ++i) { v[i] = (float)x[i]; ss += v[i] * v[i]; } }
      else {
#pragma unroll
        for (int i = 0; i < 8; ++i) v[i] = 0.f; }
      const float rstd = rsqrtf(wave_sum(ss) * (1.f / 256.f) + EPS);
      if (lane < 32) { h16x8 o;
#pragma unroll
        for (int i = 0; i < 8; ++i) o[i] = (h16)(v[i] * rstd * gkv[lane * 8 + i]);
        *(h16x8*)(CKVN + (size_t)row * 256 + lane * 8) = o; }
    }
    {
      const int part = lane & 3, head = lane >> 2;
      const h16x8 x = __builtin_bit_cast(h16x8, xr_);
      float v[8], w[8];
#pragma unroll
      for (int i = 0; i < 8; ++i) { v[i] = (float)x[i]; w[i] = xor_swz<1>(v[i]); }
      if (s >= NCTX) {
        const int t = s - NCTX; const int pos = (part < 2) ? (t >> 6) : (t & 63);
        const f32x2* tb = (const f32x2*)T32 + pos * 8;
#pragma unroll
        for (int i = 0; i < 8; ++i) { const f32x2 cs = tb[i];
          v[i] = (part & 1) ? (v[i] * cs[0] + w[i] * cs[1]) : (v[i] * cs[0] - w[i] * cs[1]); }
      }
      h16x8 o;
#pragma unroll
      for (int i = 0; i < 8; ++i) o[i] = (h16)v[i];
      *(h16x8*)(Kb + ((size_t)(b * 16 + head) * SALL + s) * 96 + 64 + part * 8) = o;
    }
  }
}

__device__ __forceinline__ void phase_gemm_mla2(const P& p, const int wv, unsigned char* smem) {
  unsigned char* ws = p.ws; LAUNDER_S(ws);
  const int tid0 = tid_now(wv);
  const h16* CQN = (const h16*)(ws + OFF_HN);
  const h16* CKVN = CQN + (size_t)NR * 384;
  const h16* Wuq = (const h16*)(ws + OFF_W) + W_MIX + 786432;
  const h16* Wukv = (const h16*)(ws + OFF_W) + W_MIX + 1376256;
  h16* Qb = (h16*)(ws + OFF_Q); h16* Kb = (h16*)(ws + OFF_K); h16* Vt = (h16*)(ws + OFF_VT);
  const float* T32 = (const float*)(ws + OFF_T32);
  const float qscale = 0.10206207261596577f * LOG2E;
  const int ntiles = 132 * 14;
  for (int step = 0; step * (int)gridDim.x < ntiles; ++step) {
    const int t = tile_u(step);
    if (t >= ntiles) continue;
    int tid = tid_now(wv);
    int mt_g, nn;
    if (t < 128 * 14) { int lm; tile_band(t, 14, lm, nn); mt_g = (lm >> 5) * 33 + 1 + (lm & 31); }
    else { int cm; tile_band(t - 128 * 14, 14, cm, nn); mt_g = cm * 33; }
    int arow[4];
#pragma unroll
    for (int j = 0; j < 4; ++j) arow[j] = mt_g * 256 + (tid >> 3) + 64 * j;
    f32x16 acc[4][2];
    const int trow = tid & 255, sh = tid >> 8;
    const int grow = mt_g * 256 + trow;
    const int b = grow / SALL, s = grow - b * SALL;
    if (nn < 6) {
      gemm_mainloop(CQN, 384, arow, Wuq, 384, nn * 256, smem, acc, tid);
      stage_acc(acc, smem, tid);
      const h16* st = (const h16*)smem + trow * SPITCH;
#pragma unroll 1
      for (int i2 = 0; i2 < 16; ++i2) {
        const int i = sh * 16 + i2;
        const int c0 = nn * 256 + i * 8, head = c0 / 96, dd = c0 - head * 96;
        h16* dst = Qb + ((size_t)(b * 16 + head) * SALL + s) * 96 + dd;
        if (dd < 64) {
          const h16x8 x = *(const h16x8*)(st + i * 8); h16x8 o;
#pragma unroll
          for (int e = 0; e < 8; ++e) o[e] = (h16)((float)x[e] * qscale);
          *(h16x8*)dst = o;
        } else if (dd == 64) {
          float v[32];
#pragma unroll
          for (int c = 0; c < 4; ++c) { const h16x8 x = *(const h16x8*)(st + (i + c) * 8);
#pragma unroll
            for (int e = 0; e < 8; ++e) v[c * 8 + e] = (float)x[e]; }
          if (s >= NCTX) {
            const int tt = s - NCTX;
            const f32x2* tr = (const f32x2*)T32 + (tt >> 6) * 8;
            const f32x2* tc = (const f32x2*)T32 + (tt & 63) * 8;
#pragma unroll
            for (int f = 0; f < 8; ++f) {
              const f32x2 a = tr[f], c = tc[f];
              const float x1 = v[f], x2 = v[8 + f], x3 = v[16 + f], x4 = v[24 + f];
              v[f] = x1 * a[0] - x2 * a[1]; v[8 + f] = x2 * a[0] + x1 * a[1];
              v[16 + f] = x3 * c[0] - x4 * c[1]; v[24 + f] = x4 * c[0] + x3 * c[1];
            }
          }
#pragma unroll
          for (int c = 0; c < 4; ++c) { h16x8 o;
#pragma unroll
            for (int e = 0; e < 8; ++e) o[e] = (h16)(v[c * 8 + e] * qscale);
            *(h16x8*)(dst + c * 8) = o; }
        }
      }
    } else {
      gemm_mainloop(CKVN, 256, arow, Wukv, 256, (nn - 6) * 256, smem, acc, tid);
      stage_acc(acc, smem, tid);
      {
        const int head = (nn - 6) * 2 + sh;
        const h16* st = (const h16*)smem + trow * SPITCH + sh * 128;
        h16* dst = Kb + ((size_t)(b * 16 + head) * SALL + s) * 96;
#pragma unroll
        for (int c = 0; c < 8; ++c) *(h16x8*)(dst + c * 8) = *(const h16x8*)(st + c * 8);
        h16* vd = Vt + (size_t)(b * 16 + head) * 64 * SALL + swap23(s);
#pragma unroll
        for (int c = 0; c < 8; ++c) { const h16x8 x = *(const h16x8*)(st + 64 + c * 8);
#pragma unroll
          for (int e = 0; e < 8; ++e) vd[(size_t)(c * 8 + e) * SALL] = x[e]; }
      }
    }
    __syncthreads();
  }
}

__device__ __forceinline__ void phase_gemm_ffnup(const P& p, const int wv, int l, bool ctx_out, unsigned char* smem) {
  unsigned char* ws = p.ws; LAUNDER_S(ws);
  const int tid0 = tid_now(wv);
  const h16* HN = (const h16*)(ws + OFF_HN);
  const h16* Wt = (const h16*)(ws + OFF_W) + W_UP;
  h16* ACT = (h16*)(ws + OFF_BIG);
  const float* cw = p.in[9] + (size_t)l * 3 * 5632;
  const float* cb = p.in[10] + (size_t)l * 5632;
  const int ntiles = 136 * 22;
  for (int step = 0; step * (int)gridDim.x < ntiles; ++step) {
    const int t = tile_u(step);
    if (t >= ntiles) continue;
    int tid = tid_now(wv);
    int mt_g, jt;
    if (t < 132 * 22) { int lm; tile_band(t, 22, lm, jt); mt_g = (lm / 33) * 34 + 1 + (lm % 33); }
    else { int cm; tile_band(t - 132 * 22, 22, cm, jt); mt_g = cm * 34; }
    const int b = mt_g / 34, ti0 = mt_g - b * 34;
    const bool isctx = ti0 == 0;
    if (isctx && !ctx_out) continue;
    const int ti = isctx ? 0 : ti0 - 1;
    const int len = isctx ? NCTX : SEQ;
    const int rowbase = b * SALL + (isctx ? 0 : NCTX);
    const int p0 = isctx ? 0 : 254 * ti - 1;
    int arow[4];
#pragma unroll
    for (int j = 0; j < 4; ++j) { const int pp = p0 + (tid >> 3) + 64 * j; arow[j] = (pp >= 0 && pp < len) ? rowbase + pp : -1; }
    f32x16 acc[4][2];
    gemm_mainloop(HN, 1024, arow, Wt, 1024, jt * 256, smem, acc, tid, 0, -1, true);
    stage_acc(acc, smem, tid);
    const int jc = tid & 15, rbase = tid >> 4;
    const int cv = jt * 128 + jc * 8, cg_ = FFN + cv;
    h16x8 w0v, w1v, w2v, bv, w0g, w1g, w2g, bg;
#pragma unroll
    for (int i = 0; i < 8; ++i) {
      w0v[i] = (h16)cw[cv + i]; w1v[i] = (h16)cw[5632 + cv + i]; w2v[i] = (h16)cw[2 * 5632 + cv + i]; bv[i] = (h16)cb[cv + i];
      w0g[i] = (h16)cw[cg_ + i]; w1g[i] = (h16)cw[5632 + cg_ + i]; w2g[i] = (h16)cw[2 * 5632 + cg_ + i]; bg[i] = (h16)cb[cg_ + i];
    }
    const h16* st = (const h16*)smem;
    const int lo = isctx ? 0 : 1, hi = isctx ? 255 : 254;
#pragma unroll 1
    for (int it = 0; it < 8; ++it) {
      const int sr = rbase + 32 * it;
      const int pp = p0 + sr;
      if (sr >= lo && sr <= hi && pp < len) {
        const h16* r1 = st + sr * SPITCH + jc * 8;
        h16x8 va, vc, ga, gc;
#pragma unroll
        for (int i = 0; i < 8; ++i) { va[i] = (h16)0.f; vc[i] = (h16)0.f; ga[i] = (h16)0.f; gc[i] = (h16)0.f; }
        if (sr > 0 && pp > 0) { va = *(const h16x8*)(r1 - SPITCH); ga = *(const h16x8*)(r1 - SPITCH + 128); }
        if (sr < 255 && pp + 1 < len) { vc = *(const h16x8*)(r1 + SPITCH); gc = *(const h16x8*)(r1 + SPITCH + 128); }
        const h16x8 vb = *(const h16x8*)r1, gb = *(const h16x8*)(r1 + 128);
        const h16x8 uv = va * w0v + vb * w1v + vc * w2v + bv;
        const h16x8 ug = ga * w0g + gb * w1g + gc * w2g + bg;
        const h16x8 tt = ug * uv;
        h16x8 sg;
#pragma unroll
        for (int i = 0; i < 8; ++i) sg[i] = (h16)__builtin_amdgcn_rcpf(1.f + __expf(-(float)ug[i]));
        const h16x8 o = tt * sg;
        *(h16x8*)(ACT + (size_t)(rowbase + pp) * FFN + cv) = o;
      }
    }
    __syncthreads();
  }
}

template <int DQK, int DV, int MODE, int NJ>
__device__ __forceinline__ void attn_item(const h16* __restrict__ Qb, const h16* __restrict__ Kb, const h16* __restrict__ Vtb, h16* __restrict__ O,
                                          int HQ, int HK, int HV, int KDIV, int VDIV, int b, int h, int qt, const float* rpb_h, float lam,
                                          const float* subg, float post, unsigned char* smem, const int tid) {
  constexpr int KROW = (DQK == 64) ? 128 : 256;
  constexpr int KT_BYTES = 64 * KROW, VT_BYTES = DV * 128, BUF = KT_BYTES + VT_BYTES;
  constexpr int KCH = 64 * (DQK / 8);
  constexpr int NKC = (KCH + 511) / 512;
  constexpr int NVC = DV * 8 / 512;
  constexpr int NDT = DV / 32, NS = DQK / 16;
  constexpr int OP = DV + 8;
  const int lane = tid & 63, wid = tid >> 6, r = lane & 31, hh = lane >> 5;
  const bool ctxq = qt == 0;
  const int q0 = qt * 256;
  int ntiles = ctxq ? 4 : 132;
  const int rot = ctxq ? 0 : (((qt - 1) & 31) * 33) >> 3;
  int bs = 0, rq = 0, qcol = 0, rsq = 0, cs = 0;
  float* rpbL = (float*)(smem + 49152);
  if (MODE == 1) {
    if (!ctxq) {
      const int r0 = 4 * (qt - 1);
      bs = min(max(r0 - 4, 0), 120);
      const int be = min(max(r0 + 3 - 4, 0), 120) + 8;
      ntiles = 4 + (be - bs);
      rq = r0 + (wid >> 1); qcol = (wid & 1) * 32 + r;
      rsq = min(max(rq - 4, 0), 120); cs = min(max(qcol - 8, 0), 48);
    }
    __syncthreads();
    for (int i = tid; i < 465; i += 512) rpbL[i] = rpb_h[i] * LOG2E;
  }
  const unsigned lds0 = (unsigned)(uintptr_t)smem;
  unsigned koff[NS], voff[4];
#pragma unroll
  for (int s = 0; s < NS; ++s) { const int c = 2 * s + hh;
    koff[s] = lds0 + ((DQK == 64) ? (r * 128 + ((c ^ ((r >> 1) & 7)) << 4)) : (r * 256 + ((c ^ (r & 15)) << 4))); }
#pragma unroll
  for (int s = 0; s < 4; ++s) { const int c = 2 * s + hh; voff[s] = lds0 + KT_BYTES + r * 128 + ((c ^ ((r >> 1) & 7)) << 4); }
#define DSR(dst, addr, imm) asm volatile("ds_read_b128 %0, %1 offset:%2" : "=v"(dst) : "v"(addr), "i"(imm))
#define WAIT8(f) asm volatile("s_waitcnt lgkmcnt(0)" : "+v"(f[0]), "+v"(f[1]), "+v"(f[2]), "+v"(f[3]), "+v"(f[4]), "+v"(f[5]), "+v"(f[6]), "+v"(f[7]))
#pragma unroll 1
  for (int jj = 0; jj < NJ; ++jj) {
    const int hq = (NJ == 2) ? 2 * h + jj : h;
    const h16* Qp = Qb + ((size_t)(b * HQ + hq) * SALL + q0 + wid * 32 + r) * DQK + hh * 8;
    const h16* Kp = Kb + (size_t)(b * HK + hq / KDIV) * SALL * DQK;
    const h16* Vp = Vtb + (size_t)(b * HV + hq / VDIV) * DV * SALL;
    h16x8 qf[NS];
#pragma unroll
    for (int s = 0; s < NS; ++s) qf[s] = __builtin_bit_cast(h16x8, GLD16(Qp + s * 16));
    f32x16 o[NDT];
#pragma unroll
    for (int dt = 0; dt < NDT; ++dt)
#pragma unroll
      for (int e = 0; e < 16; ++e) o[dt][e] = 0.f;
    float m = 0.f, lsum = 0.f;
    f32x16 negm;
#pragma unroll
    for (int e = 0; e < 16; ++e) negm[e] = 0.f;
    u32x4 rk[NKC], rv[NVC];
#define KV0(t) ((MODE == 1) ? ((!ctxq && (t) >= 4) ? (NCTX + (bs + (t) - 4) * 64) : ((t) * 64)) : ((((t) + rot) >= ntiles ? ((t) + rot - ntiles) : ((t) + rot)) * 64))
#define TLOAD(t) { const int kv0_ = KV0(t); \
      _Pragma("unroll") for (int i = 0; i < NKC; ++i) { const int ci = tid + 512 * i; if (ci < KCH) rk[i] = GLD16(Kp + (size_t)kv0_ * DQK + ci * 8); } \
      _Pragma("unroll") for (int i = 0; i < NVC; ++i) { const int ci = tid + 512 * i; rv[i] = GLD16(Vp + (size_t)(ci >> 3) * SALL + kv0_ + (ci & 7) * 8); } }
#define TWRITE(bf) { unsigned char* kb_ = smem + (bf) * BUF; \
      _Pragma("unroll") for (int i = 0; i < NKC; ++i) { const int ci = tid + 512 * i; if (ci < KCH) { \
        if (DQK == 64) { const int row = ci >> 3, c = ci & 7; *(u32x4*)(kb_ + row * 128 + ((c ^ ((row >> 1) & 7)) << 4)) = rk[i]; } \
        else { const int row = ci / 12, c = ci - row * 12; *(u32x4*)(kb_ + row * 256 + ((c ^ (row & 15)) << 4)) = rk[i]; } } } \
      _Pragma("unroll") for (int i = 0; i < NVC; ++i) { const int ci = tid + 512 * i; const int d = ci >> 3, c = ci & 7; \
        *(u32x4*)(kb_ + KT_BYTES + d * 128 + ((c ^ ((d >> 1) & 7)) << 4)) = rv[i]; } }
    TLOAD(0)
    __syncthreads();
    TWRITE(0)
    __syncthreads();
    for (int t = 0; t < ntiles; ++t) {
      const int buf = t & 1;
      if (t + 1 < ntiles) TLOAD(t + 1)
      bool active = true; int krow = 0;
      if (MODE == 1 && !ctxq && t >= 4) { krow = bs + t - 4; active = (krow >= rsq) && (krow < rsq + 8); }
      if (active) {
        const unsigned char* kb = smem + buf * BUF;
        const unsigned char* vb = kb + KT_BYTES;
        f32x16 p0, p1;
        const unsigned bofs = (unsigned)(buf * BUF);
        {
          h16x8 kf[2 * NS];
#pragma unroll
          for (int s = 0; s < NS; ++s) { DSR(kf[2 * s], koff[s] + bofs, 0); DSR(kf[2 * s + 1], koff[s] + bofs, 32 * KROW); }
          WAIT8(kf);
          if (NS > 4) asm volatile("" : "+v"(kf[8]), "+v"(kf[9]), "+v"(kf[10 % (2 * NS)]), "+v"(kf[11 % (2 * NS)]));
          p0 = MFMA(kf[0], qf[0], negm); p1 = MFMA(kf[1], qf[0], negm);
#pragma unroll
          for (int s = 1; s < NS; ++s) { p0 = MFMA(kf[2 * s], qf[s], p0); p1 = MFMA(kf[2 * s + 1], qf[s], p1); }
        }
        h16x8 vf[8];
#pragma unroll
        for (int i = 0; i < 8; ++i) DSR(vf[i], voff[i & 3] + bofs, (i >> 2) * 4096);
        if (MODE == 1 && !ctxq && t >= 4) {
          const int dr = krow - rq + 7;
#pragma unroll
          for (int e = 0; e < 16; ++e) {
            const int kc0 = crow(e, hh), kc1 = 32 + kc0;
            const bool in0 = (kc0 >= cs) && (kc0 < cs + 16), in1 = (kc1 >= cs) && (kc1 < cs + 16);
            const int i0 = in0 ? dr * 31 + kc0 - qcol + 15 : 0, i1 = in1 ? dr * 31 + kc1 - qcol + 15 : 0;
            const float b0v = rpbL[i0], b1v = rpbL[i1];
            p0[e] = in0 ? p0[e] + b0v : -1e30f;
            p1[e] = in1 ? p1[e] + b1v : -1e30f;
          }
        }
        float mx = xhalf_max(rowmax32(p0, p1));
        if (t == 0 || __builtin_amdgcn_ballot_w64(mx > 8.f) != 0) {
          const float d = (t == 0) ? mx : fmaxf(mx, 0.f);
          m += d;
#pragma unroll
          for (int e = 0; e < 16; ++e) { p0[e] -= d; p1[e] -= d; negm[e] = -m; }
          if (t != 0) {
            const float alpha = fexp2(-d);
            lsum *= alpha;
#pragma unroll
            for (int dt = 0; dt < NDT; ++dt)
#pragma unroll
              for (int e = 0; e < 16; ++e) o[dt][e] *= alpha;
          }
        }
#pragma unroll
        for (int e = 0; e < 16; ++e) { p0[e] = fexp2(p0[e]); p1[e] = fexp2(p1[e]); }
        {
          const f32x16 ps = p0 + p1;
          lsum += ((ps[0] + ps[1]) + (ps[2] + ps[3])) + ((ps[4] + ps[5]) + (ps[6] + ps[7])) + ((ps[8] + ps[9]) + (ps[10] + ps[11])) + ((ps[12] + ps[13]) + (ps[14] + ps[15]));
        }
        h16x8 pb[4];
        {
          u32x4 w0, w1, w2, w3;
#pragma unroll
          for (int e = 0; e < 4; ++e) { w0[e] = pk_h2(p0[2 * e], p0[2 * e + 1]); w1[e] = pk_h2(p0[8 + 2 * e], p0[9 + 2 * e]);
                                        w2[e] = pk_h2(p1[2 * e], p1[2 * e + 1]); w3[e] = pk_h2(p1[8 + 2 * e], p1[9 + 2 * e]); }
          pb[0] = __builtin_bit_cast(h16x8, w0); pb[1] = __builtin_bit_cast(h16x8, w1); pb[2] = __builtin_bit_cast(h16x8, w2); pb[3] = __builtin_bit_cast(h16x8, w3);
        }
        WAIT8(vf);
        if (NDT == 4) {
#pragma unroll
          for (int i = 0; i < 8; ++i) o[i >> 2] = MFMA(vf[i], pb[i & 3], o[i >> 2]);
          h16x8 vg[8];
#pragma unroll
          for (int i = 0; i < 4; ++i) DSR(vg[i], voff[i & 3] + bofs, 8192);
#pragma unroll
          for (int i = 4; i < 8; ++i) DSR(vg[i], voff[i & 3] + bofs, 12288);
          WAIT8(vg);
#pragma unroll
          for (int i = 0; i < 8; ++i) o[(2 + (i >> 2)) % NDT] = MFMA(vg[i], pb[i & 3], o[(2 + (i >> 2)) % NDT]);
        } else {
#pragma unroll
          for (int i = 0; i < 8; ++i) o[(i >> 2) % NDT] = MFMA(vf[i], pb[i & 3], o[(i >> 2) % NDT]);
        }
      }
      if (t + 1 < ntiles) TWRITE(buf ^ 1)
      __syncthreads();
    }
#undef DSR
#undef WAIT8
#undef KV0
#undef TLOAD
#undef TWRITE
    const float lt = xhalf_sum(lsum);
    const float inv = 1.f / lt;
#pragma unroll
    for (int dt = 0; dt < NDT; ++dt)
#pragma unroll
      for (int e = 0; e < 16; ++e) o[dt][e] *= inv;
    h16* st = (h16*)smem + wid * 32 * OP;
#pragma unroll
    for (int dt = 0; dt < NDT; ++dt)
#pragma unroll
      for (int g4 = 0; g4 < 4; ++g4) {
        h16x4 w;
#pragma unroll
        for (int i = 0; i < 4; ++i) w[i] = (h16)o[dt][4 * g4 + i];
        *(h16x4*)(st + r * OP + dt * 32 + 8 * g4 + 4 * hh) = w;
      }
    __syncthreads();
    constexpr int CPR = DV / 8, RPP = 64 / CPR;
#pragma unroll
    for (int ps = 0; ps < 32 / RPP; ++ps) {
      const int q = ps * RPP + lane / CPR, c = lane % CPR;
      h16* op = O + (size_t)(b * SALL + q0 + wid * 32 + q) * 1024 + h * DV + c * 8;
      if (NJ == 2 && jj == 1) {
        const h16x8 x1 = *(const h16x8*)(st + q * OP + c * 8);
        const h16x8 x0 = *(const h16x8*)op;
        float xv[8]; float ss = 0.f;
#pragma unroll
        for (int i = 0; i < 8; ++i) { xv[i] = (float)x0[i] - lam * (float)x1[i]; ss += xv[i] * xv[i]; }
        ss += xor_swz<1>(ss); ss += xor_swz<2>(ss); ss += xor_swz<4>(ss); ss += xor_swz<8>(ss);
        const float rstd = rsqrtf(ss * (1.f / (float)DV) + EPS) * post;
        h16x8 ov;
#pragma unroll
        for (int i = 0; i < 8; ++i) ov[i] = (h16)(xv[i] * rstd * subg[c * 8 + i]);
        *(h16x8*)op = ov;
      } else {
        const u32x4 v = *(const u32x4*)(st + q * OP + c * 8);
        *(u32x4*)op = v;
      }
    }
  }
}

template <int DQK, int DV, int MODE, int NJ>
__device__ __forceinline__ void attn_phase_t(const P& p, const int wv, int H, int HK, int HV, int KDIV, int VDIV, bool ctx_out, const float* rpb, float lam,
                                             const float* subg, float post, unsigned char* smem) {
  unsigned char* ws = p.ws; LAUNDER_S(ws);
  const int tid0 = tid_now(wv);
  const h16* Qb = (const h16*)(ws + OFF_Q); const h16* Kb = (const h16*)(ws + OFF_K); const h16* Vt = (const h16*)(ws + OFF_VT);
  h16* O = (h16*)(ws + OFF_HN);
  const int heavy = NB * H * 32;
  const int total = heavy + (ctx_out ? NB * H : 0);
  for (int it = blockIdx.x; it < total; it += gridDim.x) {
    int tid = tid_now(wv);
    int bh, qt;
    if (it < heavy) { const int grp = it >> 8, loc = it & 255; bh = grp * 8 + (loc & 7); qt = 1 + (loc >> 3); }
    else { bh = it - heavy; qt = 0; }
    const int b = bh / H, h = bh - b * H;
    attn_item<DQK, DV, MODE, NJ>(Qb, Kb, Vt, O, 16, HK, HV, KDIV, VDIV, b, h, qt, MODE == 1 ? rpb + (size_t)h * 465 : nullptr, lam, subg, post, smem, tid);
  }
}

__device__ __forceinline__ void phase_attention(const P& p, const int wv, int mixer, bool ctx_out, unsigned char* smem) {
  if (mixer == 0) attn_phase_t<64, 64, 0, 1>(p, wv, 16, 4, 4, 4, 4, ctx_out, nullptr, 0.f, nullptr, 1.f, smem);
  else if (mixer == 1) attn_phase_t<96, 64, 0, 1>(p, wv, 16, 16, 16, 1, 1, ctx_out, nullptr, 0.f, nullptr, 1.f, smem);
  else if (mixer == 2) {
    const float* lf = p.in[23];
    float d1 = 0.f, d2 = 0.f;
    for (int i = 0; i < 64; ++i) { d1 += lf[i] * lf[64 + i]; d2 += lf[128 + i] * lf[192 + i]; }
    const float li = 0.8f - 0.6f * expf(-0.3f * 2.f);
    const float lam = expf(d1) - expf(d2) + li;
    attn_phase_t<64, 128, 0, 2>(p, wv, 8, 16, 8, 1, 2, ctx_out, nullptr, lam, p.in[24], 1.f - li, smem);
  } else attn_phase_t<64, 64, 1, 1>(p, wv, 16, 16, 16, 1, 1, ctx_out, p.in[27], 0.f, nullptr, 1.f, smem);
}

__device__ __forceinline__ void fast_grid_barrier(unsigned* ctr, unsigned& epoch) {
  __syncthreads();
  epoch += 1u;
  if (threadIdx.x == 0) {
    __builtin_amdgcn_fence(__ATOMIC_RELEASE, "agent");
    const unsigned ngrp = gridDim.x >> 3;
    if ((gridDim.x & 7u) == 0u) {
      const unsigned old = __hip_atomic_fetch_add(ctr + 16u * (blockIdx.x & 7u), 1u, __ATOMIC_ACQ_REL, __HIP_MEMORY_SCOPE_AGENT);
      if (old == epoch * ngrp - 1u) __hip_atomic_fetch_add(ctr + 192, 1u, __ATOMIC_RELEASE, __HIP_MEMORY_SCOPE_AGENT);
      const unsigned target = epoch * 8u;
      while (__hip_atomic_load(ctr + 192, __ATOMIC_RELAXED, __HIP_MEMORY_SCOPE_AGENT) < target) __builtin_amdgcn_s_sleep(1);
    } else {
      __hip_atomic_fetch_add(ctr + 192, 1u, __ATOMIC_RELAXED, __HIP_MEMORY_SCOPE_AGENT);
      const unsigned target = epoch * gridDim.x;
      while (__hip_atomic_load(ctr + 192, __ATOMIC_RELAXED, __HIP_MEMORY_SCOPE_AGENT) < target) __builtin_amdgcn_s_sleep(1);
    }
    __builtin_amdgcn_fence(__ATOMIC_ACQUIRE, "agent");
  }
  __syncthreads();
}

__device__ __forceinline__ bool phase_exists(int ph) {
  if (ph == 0 || ph == NPH - 1) return true;
  const int l = (ph - 1) / 9, q = (ph - 1) % 9;
  if ((q == 2 || q == 3) && l != 1) return false;
  return true;
}

__global__ void __launch_bounds__(512, 2) fwd_megakernel(P p) {
  __shared__ __attribute__((aligned(16))) unsigned char smem[135168];
  cg::grid_group grid = cg::this_grid();
  const int wv = __builtin_amdgcn_readfirstlane((int)__builtin_amdgcn_workitem_id_x() >> 6);
  bool first = true;
  int nsync = 0; unsigned bar_epoch = 0u;
  unsigned* bar_ctr = (unsigned*)(p.ws + OFF_CTL);
  for (int ph = p.ph_lo; ph < p.ph_hi; ++ph) {
    if (!phase_exists(ph)) continue;
    if (!first) { if (nsync == 0) grid.sync(); else fast_grid_barrier(bar_ctr, bar_epoch); ++nsync; }
    first = false;
    if (ph == 0) { phase_prep(p, wv, smem); continue; }
    if (ph == NPH - 1) { phase_final(p, wv); continue; }
    const int l = (ph - 1) / 9, q = (ph - 1) % 9;
    const bool ctx_out = l < 3;
    const h16* W = (const h16*)(p.ws + OFF_W);
#ifdef PROBE_REPEAT_MASK
    for (int rep = 0; rep < (((PROBE_REPEAT_MASK) >> q) & 1 ? 2 : 1); ++rep) {
    if (rep) grid.sync();
#endif
    switch (q) {
      case 0: if (l > 0) convert_weights(p, wv, l, smem); phase_modnorm(p, wv, l, 0); break;
      case 1: if (l == 1) phase_gemm_mla1(p, wv, smem); else phase_gemm_inproj(p, wv, l, smem); break;
      case 2: phase_mla_rownorm(p, wv); break;
      case 3: phase_gemm_mla2(p, wv, smem); break;
      case 4: phase_attention(p, wv, l, ctx_out, smem); break;
      case 5: {
        const size_t wo = W_MIX + (l == 0 ? 1572864 : (l == 1 ? 1900544 : 3145728));
        phase_gemm_resid(p, wv, l, (const h16*)(p.ws + OFF_HN), 1024, W + wo, 2, ctx_out, smem); break; }
      case 6: phase_modnorm(p, wv, l, 1); break;
      case 7: phase_gemm_ffnup(p, wv, l, ctx_out, smem); break;
      case 8: phase_gemm_resid(p, wv, l, (const h16*)(p.ws + OFF_BIG), FFN, W + W_DN, 5, ctx_out, smem); break;
    }
#ifdef PROBE_REPEAT_MASK
    }
#endif
  }
}

extern "C" void kernel_launch(void* const* d_in, const int* in_sizes, int n_in, void* d_out, int out_size, void* d_ws, size_t ws_size,
                              hipStream_t stream) {
  static int grid_blocks = 0;
  if (!grid_blocks) {
    int dev = 0, cus = 0, per_cu = 0;
    (void)hipGetDevice(&dev);
    (void)hipDeviceGetAttribute(&cus, hipDeviceAttributeMultiprocessorCount, dev);
    (void)hipOccupancyMaxActiveBlocksPerMultiprocessor(&per_cu, fwd_megakernel, 512, 0);
    if (per_cu > 1) per_cu = 1;
    if (per_cu < 1) per_cu = 1;
    grid_blocks = cus * per_cu;
    if (ws_size < WS_END || n_in != 30) fprintf(stderr, "kernel_launch: workspace %zu < %zu or n_in %d != 30\n", ws_size, (size_t)WS_END, n_in);
  }
  P p{};
  for (int i = 0; i < 30; ++i) p.in[i] = (const float*)d_in[i];
  p.out = (float*)d_out; p.ws = (unsigned char*)d_ws; p.ph_lo = 0; p.ph_hi = NPH;
  (void)hipMemsetAsync((unsigned char*)d_ws + OFF_CTL, 0, 1024, stream);
  void* args[] = {&p};
  hipError_t e = hipLaunchCooperativeKernel((void*)fwd_megakernel, dim3(grid_blocks), dim3(512), args, 0, stream);
  if (e != hipSuccess) fprintf(stderr, "cooperative launch failed: %s (grid %d)\n", hipGetErrorString(e), grid_blocks);
}
```
